# Optimizing an MI355X kernel written in HIP

```python
import math
import jax, jax.numpy as jnp
from jax import lax
import numpy as np

D_MODEL = 2048
BATCH = 4
SEQ = 2048
DEPTH = 2
DEC_BATCH = 128
DEC_SEQ = 4
PAST_LEN = 16384
PAGE_SIZE = 128

MIX_WIDTH = D_MODEL
RW_WIDTH = MIX_WIDTH // 2
RW_HEAD = 64
RW_HEADS = RW_WIDTH // RW_HEAD
RW_DECAY_LORA = D_MODEL // 32
RW_AAA_LORA = D_MODEL // 32
RW_GATE_LORA = D_MODEL // 16
RW_COLS = 3 * RW_WIDTH + RW_DECAY_LORA + RW_AAA_LORA + RW_GATE_LORA
GD_WIDTH = MIX_WIDTH - RW_WIDTH
GD_HEAD = 128
GD_HEADS = GD_WIDTH // GD_HEAD
GD_CONV = 4
GD_CHUNK = 64
GD_COLS = 4 * GD_WIDTH + 2 * GD_HEADS
IN_COLS = RW_COLS + GD_COLS
N_MEM = 256
XA_HEADS = 4
XA_HEAD = 128
XA_WIDTH = XA_HEADS * XA_HEAD
D_FF = -(-8 * D_MODEL // (3 * 256)) * 256
DEEPNORM_ALPHA = (2 * DEPTH) ** 0.25
DEEPNORM_BETA = (8 * DEPTH) ** -0.25
LN_EPS = 1e-5
RW_GN_EPS = 64e-5
GD_NORM_EPS = 1e-6

kernel_name = 'hybrid_rwkv7_gdn_memxattn_step'


def _layer_norm(x, g, b):
    xf = x.astype(jnp.float32)
    mu = jnp.mean(xf, -1, keepdims=True)
    var = jnp.mean(jnp.square(xf - mu), -1, keepdims=True)
    return ((xf - mu) * lax.rsqrt(var + LN_EPS) * g + b).astype(x.dtype)


def _l2norm(t):
    return t * lax.rsqrt(jnp.sum(t * t, -1, keepdims=True) + 1e-12)


def _rwkv7_mix(p, prev, S0, mu, w0, w2, a0, a2, g2, k_k, k_a, r_k, lnx_w, lnx_b):
    f32 = jnp.float32
    B, T, _ = p.shape
    p = p.astype(f32)
    shifted = jnp.concatenate([prev.astype(f32)[:, None], p[:, :-1]], axis=1)
    m = p + (shifted - p) * mu
    c0, c1, c2, c3 = RW_WIDTH, 2 * RW_WIDTH, 3 * RW_WIDTH, 3 * RW_WIDTH + RW_DECAY_LORA
    c4 = c3 + RW_AAA_LORA
    r, k, v = m[..., :c0], m[..., c0:c1], m[..., c1:c2]
    wd, ad, gd = m[..., c2:c3], m[..., c3:c4], m[..., c4:]
    w_log = -jax.nn.softplus(-(w0 + jnp.tanh(wd) @ w2)) - 0.5
    decay = jnp.exp(-jnp.exp(w_log))
    a = jax.nn.sigmoid(a0 + ad @ a2)
    g = jax.nn.sigmoid(gd) @ g2
    hs = lambda t: t.reshape(B, T, RW_HEADS, RW_HEAD)
    kk = _l2norm(hs(k * k_k))
    k = k * (1.0 + (a - 1.0) * k_a)
    r, k, v, decay, a = hs(r), hs(k), hs(v), hs(decay), hs(a)
    in_a = -kk
    in_b = kk * a

    def step(S, inp):
        r_t, w_t, k_t, v_t, a_t, b_t = inp
        Sa = jnp.einsum('bhvk,bhk->bhv', S, a_t)
        S = S * w_t[:, :, None, :] + Sa[..., None] * b_t[:, :, None, :] + v_t[..., None] * k_t[:, :, None, :]
        return S, jnp.einsum('bhvk,bhk->bhv', S, r_t)

    tm = lambda t: jnp.swapaxes(t, 0, 1)
    S, o = lax.scan(step, S0.astype(f32), (tm(r), tm(decay), tm(k), tm(v), tm(in_a), tm(in_b)))
    o = tm(o)
    o_mu = jnp.mean(o, -1, keepdims=True)
    o_var = jnp.mean(jnp.square(o - o_mu), -1, keepdims=True)
    o = ((o - o_mu) * lax.rsqrt(o_var + RW_GN_EPS)).reshape(B, T, RW_WIDTH) * lnx_w + lnx_b
    bonus = jnp.sum(r * k * r_k, -1, keepdims=True) * v
    o = (o + bonus.reshape(B, T, RW_WIDTH)) * g
    return o, S, p[:, -1]


def _chunk_gated_delta(q, k, v, beta, g, S0):
    B, T, H, Dk = q.shape
    Dv = v.shape[-1]
    C = min(GD_CHUNK, T)
    n = -(-T // C)
    pad = n * C - T

    def blk(t):
        t = jnp.pad(t, [(0, 0), (0, pad)] + [(0, 0)] * (t.ndim - 2))
        t = jnp.moveaxis(t, 2, 1)
        return t.reshape(t.shape[:2] + (n, C) + t.shape[3:])

    q, k, v, beta, g = blk(q), blk(k), blk(v), blk(beta), blk(g)
    G = jnp.cumsum(g, -1)
    idx = jnp.arange(C)
    causal = idx[:, None] >= idx[None, :]
    strict = idx[:, None] > idx[None, :]
    decay = jnp.exp(jnp.where(causal, G[..., :, None] - G[..., None, :], -jnp.inf))
    kb = k * beta[..., None]
    L = jnp.where(strict, jnp.einsum('bhnik,bhnjk->bhnij', kb, k) * decay, 0.0)
    A = L + jnp.eye(C, dtype=L.dtype)
    rhs = jnp.concatenate([v * beta[..., None], kb * jnp.exp(G)[..., None]], -1)
    sol = lax.linalg.triangular_solve(A, rhs, left_side=True, lower=True, unit_diagonal=True)
    u, w = sol[..., :Dv], sol[..., Dv:]
    attn = jnp.einsum('bhnik,bhnjk->bhnij', q, k) * decay
    qg = q * jnp.exp(G)[..., None]
    kg = k * jnp.exp(G[..., -1:] - G)[..., None]
    gl = jnp.exp(G[..., -1])

    def step(S, inp):
        qg_c, kg_c, u_c, w_c, attn_c, gl_c = inp
        v_new = u_c - jnp.einsum('bhik,bhkv->bhiv', w_c, S)
        o = jnp.einsum('bhik,bhkv->bhiv', qg_c, S) + jnp.einsum('bhij,bhjv->bhiv', attn_c, v_new)
        S = S * gl_c[..., None, None] + jnp.einsum('bhjk,bhjv->bhkv', kg_c, v_new)
        return S, o

    mv = lambda t: jnp.moveaxis(t, 2, 0)
    S, o = lax.scan(step, S0, (mv(qg), mv(kg), mv(u), mv(w), mv(attn), mv(gl)))
    o = jnp.moveaxis(o, 0, 2).reshape(B, H, n * C, Dv)[:, :, :T]
    return jnp.moveaxis(o, 1, 2), S


def _gdn_mix(p, conv_prev, S0, conv_w, a_log, dt_bias, norm_w):
    f32 = jnp.float32
    B, T, _ = p.shape
    p = p.astype(f32)
    W3 = 3 * GD_WIDTH
    qkv = p[..., :W3]
    z = p[..., W3:W3 + GD_WIDTH]
    b_raw = p[..., W3 + GD_WIDTH:W3 + GD_WIDTH + GD_HEADS]
    a_raw = p[..., W3 + GD_WIDTH + GD_HEADS:]
    xp = jnp.concatenate([conv_prev.astype(f32), qkv], axis=1)
    conv = xp[:, 0:T] * conv_w[0]
    for j in range(1, GD_CONV):
        conv = conv + xp[:, j:j + T] * conv_w[j]
    qkv = jax.nn.silu(conv)
    hs = lambda t: t.reshape(B, T, GD_HEADS, GD_HEAD)
    q = _l2norm(hs(qkv[..., :GD_WIDTH])) * (GD_HEAD ** -0.5)
    k = _l2norm(hs(qkv[..., GD_WIDTH:2 * GD_WIDTH]))
    v = hs(qkv[..., 2 * GD_WIDTH:])
    beta = jax.nn.sigmoid(b_raw)
    g = -jnp.exp(a_log) * jax.nn.softplus(a_raw + dt_bias)
    o, S = _chunk_gated_delta(q, k, v, beta, g, S0.astype(f32))
    o = o * lax.rsqrt(jnp.mean(o * o, -1, keepdims=True) + GD_NORM_EPS) * norm_w * jax.nn.silu(hs(z))
    return o.reshape(B, T, GD_WIDTH), S, xp[:, -(GD_CONV - 1):]


def _mem_kv(mem, wk, wv):
    B = mem.shape[0]
    k = (mem @ wk).reshape(B, N_MEM, XA_HEADS, XA_HEAD)
    v = (mem @ wv).reshape(B, N_MEM, XA_HEADS, XA_HEAD)
    return k, v


def _cross_attn(x, mk, mv, wq, wo):
    B, T, _ = x.shape
    q = (x @ wq).reshape(B, T, XA_HEADS, XA_HEAD)
    s = jnp.einsum('bthd,bmhd->bhtm', q, mk).astype(jnp.float32) * (XA_HEAD ** -0.5)
    pr = jax.nn.softmax(s, axis=-1).astype(mv.dtype)
    o = jnp.einsum('bhtm,bmhd->bthd', pr, mv).reshape(B, T, XA_WIDTH).astype(x.dtype)
    return o @ wo


def _decoder_layer(x, mk, mv, rw_S, shift_prev, gd_S, conv_prev, lp):
    p = x @ lp['w_in']
    o_rw, rw_S, shift_new = _rwkv7_mix(p[..., :RW_COLS], shift_prev, rw_S, lp['mu_shift'], lp['rw_w0'], lp['rw_w2'],
                                       lp['rw_a0'], lp['rw_a2'], lp['rw_g2'], lp['rw_kk'], lp['rw_ka'], lp['rw_rk'],
                                       lp['rw_lnx_w'], lp['rw_lnx_b'])
    o_gd, gd_S, conv_new = _gdn_mix(p[..., RW_COLS:], conv_prev, gd_S, lp['gd_conv_w'], lp['gd_a_log'],
                                    lp['gd_dt_bias'], lp['gd_norm_w'])
    h = jnp.concatenate([o_rw, o_gd], -1).astype(x.dtype) @ lp['w_out']
    x = _layer_norm(DEEPNORM_ALPHA * x + h, lp['ln1_g'], lp['ln1_b'])
    x = _layer_norm(DEEPNORM_ALPHA * x + _cross_attn(x, mk, mv, lp['xa_wq'], lp['xa_wo']), lp['ln2_g'], lp['ln2_b'])
    f = (jax.nn.silu(x @ lp['ff_wg']) * (x @ lp['ff_wu'])) @ lp['ff_wd']
    x = _layer_norm(DEEPNORM_ALPHA * x + f, lp['ln3_g'], lp['ln3_b'])
    return x, rw_S, shift_new, gd_S, conv_new


def setup_inputs(seed: int = 0) -> dict:
    key = jax.random.key(seed)
    ks = iter(jax.random.split(key, 48))
    f32 = jnp.float32

    def nrm(shape, scale):
        return jax.random.normal(next(ks), shape, f32) * scale

    def unif(shape, lo, hi):
        return jax.random.uniform(next(ks), shape, f32, lo, hi)

    dt = jnp.exp(unif((DEPTH, GD_HEADS), math.log(1e-3), math.log(1e-1)))
    return {
        'x_prompt': nrm((BATCH, SEQ, D_MODEL), 1.0),
        'mem_prompt': nrm((BATCH, N_MEM, D_MODEL), 1.0),
        'x_sample': nrm((DEC_BATCH, DEC_SEQ, D_MODEL), 1.0),
        'state_rwkv': nrm((DEPTH, DEC_BATCH, RW_HEADS, RW_HEAD, RW_HEAD), 0.1),
        'state_shift': nrm((DEPTH, DEC_BATCH, RW_COLS), 1.0),
        'state_gdn': nrm((DEPTH, DEC_BATCH, GD_HEADS, GD_HEAD, GD_HEAD), 0.1),
        'state_conv': nrm((DEPTH, DEC_BATCH, GD_CONV - 1, 3 * GD_WIDTH), 1.0),
        'cache_mem_k': nrm((DEPTH, DEC_BATCH, N_MEM, XA_HEADS, XA_HEAD), 1.0),
        'cache_mem_v': nrm((DEPTH, DEC_BATCH, N_MEM, XA_HEADS, XA_HEAD), 1.0),
        'w_in': nrm((DEPTH, D_MODEL, IN_COLS), D_MODEL ** -0.5),
        'mu_shift': unif((DEPTH, RW_COLS), 0.0, 1.0),
        'rw_w0': unif((DEPTH, RW_WIDTH), -5.0, 1.0),
        'rw_w2': nrm((DEPTH, RW_DECAY_LORA, RW_WIDTH), 0.5 * RW_DECAY_LORA ** -0.5),
        'rw_a0': nrm((DEPTH, RW_WIDTH), 0.1),
        'rw_a2': nrm((DEPTH, RW_AAA_LORA, RW_WIDTH), RW_AAA_LORA ** -0.5),
        'rw_g2': nrm((DEPTH, RW_GATE_LORA, RW_WIDTH), RW_GATE_LORA ** -0.5),
        'rw_kk': 0.85 + nrm((DEPTH, RW_WIDTH), 0.02),
        'rw_ka': 1.0 + nrm((DEPTH, RW_WIDTH), 0.02),
        'rw_rk': nrm((DEPTH, RW_HEADS, RW_HEAD), 0.1),
        'rw_lnx_w': 1.0 + nrm((DEPTH, RW_WIDTH), 0.02),
        'rw_lnx_b': nrm((DEPTH, RW_WIDTH), 0.02),
        'gd_conv_w': nrm((DEPTH, GD_CONV, 3 * GD_WIDTH), GD_CONV ** -0.5),
        'gd_a_log': jnp.log(unif((DEPTH, GD_HEADS), 1.0, 16.0)),
        'gd_dt_bias': dt + jnp.log(-jnp.expm1(-dt)),
        'gd_norm_w': 1.0 + nrm((DEPTH, GD_HEAD), 0.02),
        'w_out': nrm((DEPTH, MIX_WIDTH, D_MODEL), MIX_WIDTH ** -0.5 * DEEPNORM_BETA),
        'ln1_g': 1.0 + nrm((DEPTH, D_MODEL), 0.02),
        'ln1_b': nrm((DEPTH, D_MODEL), 0.02),
        'xa_wq': nrm((DEPTH, D_MODEL, XA_WIDTH), D_MODEL ** -0.5),
        'xa_wk': nrm((DEPTH, D_MODEL, XA_WIDTH), D_MODEL ** -0.5),
        'xa_wv': nrm((DEPTH, D_MODEL, XA_WIDTH), D_MODEL ** -0.5),
        'xa_wo': nrm((DEPTH, XA_WIDTH, D_MODEL), XA_WIDTH ** -0.5 * DEEPNORM_BETA),
        'ln2_g': 1.0 + nrm((DEPTH, D_MODEL), 0.02),
        'ln2_b': nrm((DEPTH, D_MODEL), 0.02),
        'ff_wg': nrm((DEPTH, D_MODEL, D_FF), D_MODEL ** -0.5),
        'ff_wu': nrm((DEPTH, D_MODEL, D_FF), D_MODEL ** -0.5),
        'ff_wd': nrm((DEPTH, D_FF, D_MODEL), D_FF ** -0.5 * DEEPNORM_BETA),
        'ln3_g': 1.0 + nrm((DEPTH, D_MODEL), 0.02),
        'ln3_b': nrm((DEPTH, D_MODEL), 0.02),
    }


def reference(x_prompt, mem_prompt, x_sample, state_rwkv, state_shift, state_gdn, state_conv, cache_mem_k,
              cache_mem_v, w_in, mu_shift, rw_w0, rw_w2, rw_a0, rw_a2, rw_g2, rw_kk, rw_ka, rw_rk, rw_lnx_w,
              rw_lnx_b, gd_conv_w, gd_a_log, gd_dt_bias, gd_norm_w, w_out, ln1_g, ln1_b, xa_wq, xa_wk, xa_wv,
              xa_wo, ln2_g, ln2_b, ff_wg, ff_wu, ff_wd, ln3_g, ln3_b):
    f32 = jnp.float32
    Bp = x_prompt.shape[0]
    dtp = x_prompt.dtype
    yp, ys = x_prompt, x_sample
    p_rw, p_sh, p_gd, p_cv, p_mk, p_mv = [], [], [], [], [], []
    s_rw, s_sh, s_gd, s_cv = [], [], [], []
    for l in range(DEPTH):
        lp = {
            'w_in': w_in[l], 'mu_shift': mu_shift[l], 'rw_w0': rw_w0[l], 'rw_w2': rw_w2[l], 'rw_a0': rw_a0[l],
            'rw_a2': rw_a2[l], 'rw_g2': rw_g2[l], 'rw_kk': rw_kk[l], 'rw_ka': rw_ka[l], 'rw_rk': rw_rk[l],
            'rw_lnx_w': rw_lnx_w[l], 'rw_lnx_b': rw_lnx_b[l], 'gd_conv_w': gd_conv_w[l], 'gd_a_log': gd_a_log[l],
            'gd_dt_bias': gd_dt_bias[l], 'gd_norm_w': gd_norm_w[l], 'w_out': w_out[l], 'ln1_g': ln1_g[l],
            'ln1_b': ln1_b[l], 'xa_wq': xa_wq[l], 'xa_wo': xa_wo[l], 'ln2_g': ln2_g[l], 'ln2_b': ln2_b[l],
            'ff_wg': ff_wg[l], 'ff_wu': ff_wu[l], 'ff_wd': ff_wd[l], 'ln3_g': ln3_g[l], 'ln3_b': ln3_b[l],
        }
        mk, mv = _mem_kv(mem_prompt, xa_wk[l], xa_wv[l])
        yp, a1, a2, a3, a4 = _decoder_layer(
            yp, mk, mv,
            jnp.zeros((Bp, RW_HEADS, RW_HEAD, RW_HEAD), f32), jnp.zeros((Bp, RW_COLS), f32),
            jnp.zeros((Bp, GD_HEADS, GD_HEAD, GD_HEAD), f32), jnp.zeros((Bp, GD_CONV - 1, 3 * GD_WIDTH), f32), lp)
        p_rw.append(a1.astype(dtp)); p_sh.append(a2.astype(dtp)); p_gd.append(a3.astype(dtp))
        p_cv.append(a4.astype(dtp)); p_mk.append(mk); p_mv.append(mv)
        ys, b1, b2, b3, b4 = _decoder_layer(
            ys, cache_mem_k[l], cache_mem_v[l], state_rwkv[l], state_shift[l], state_gdn[l], state_conv[l], lp)
        s_rw.append(b1.astype(state_rwkv.dtype)); s_sh.append(b2.astype(state_shift.dtype))
        s_gd.append(b3.astype(state_gdn.dtype)); s_cv.append(b4.astype(state_conv.dtype))
    return (yp, ys, jnp.stack(p_rw), jnp.stack(p_sh), jnp.stack(p_gd), jnp.stack(p_cv), jnp.stack(p_mk),
            jnp.stack(p_mv), jnp.stack(s_rw), jnp.stack(s_sh), jnp.stack(s_gd), jnp.stack(s_cv))
```

```cpp
#include <hip/hip_runtime.h>
#include <hip/hip_cooperative_groups.h>
#include <cstdio>
#include <cstdint>
namespace cg = cooperative_groups;
#define DUP_MASK 0
#define SAMPLE_REPS 1
namespace pg8 {
#define PG8_LAS __attribute__((address_space(3)))
typedef unsigned short bf16_t;
typedef short bf16x8 __attribute__((ext_vector_type(8)));
typedef float f32x4 __attribute__((ext_vector_type(4)));
typedef unsigned u32x4 __attribute__((ext_vector_type(4)));
constexpr int BM = 256, BK = 64, HALF = 128, HTB = HALF * BK * 2  , STAGE_BYTES = 8 * HTB, NXCD = 8, WGM = 8;

__host__ __device__ __forceinline__ int lds_byte(int r, int c) { const int st = (r >> 4) * 2 + (c >> 5), rr = r & 15, cc = c & 31, ob = rr * 64 + cc * 2; return st * 1024 + (ob ^ (((ob >> 9) & 1) << 5)); }
__host__ __device__ __forceinline__ void stage_rc(int b, int& R, int& C) { const int st = b / 1024, sb = b % 1024, swz = sb ^ (((sb >> 9) & 1) << 5); R = (st >> 1) * 16 + swz / 64; C = (st & 1) * 32 + (swz % 64) / 2; }
__host__ __device__ __forceinline__ int perm32(int rho) { const int n = rho >> 4, i = rho & 15; return 8 * (i >> 2) + 4 * n + (i & 3); }

struct Unit { int pm, pn, kt0; };
struct Gemm { const bf16_t* A; const bf16_t* Bt; int M, N, K, nt; };

struct StaticOrder {
    int nM, nN, nwg, G, c, nsplit, nkt;
    __host__ __device__ void init(int M, int N, int G_, int c_) { nM = M / BM; nN = N / BM; nwg = nM * nN; G = G_; c = c_; nsplit = 1; nkt = 0; }
    __host__ __device__ bool next(int i, Unit& u) const {
        const long L0 = (long)i * G + c; const long tot = (long)nwg * nsplit; const bool ok = L0 < tot; const int L = ok ? (int)L0 : 0;
        int pm, pn, kt0;
        if (nsplit > 1) { const int tile = L % nwg, sp = L / nwg; pm = tile / nN; pn = tile % nN; kt0 = sp * nkt; }
        else {
            int wgid = L; { const int q = nwg / NXCD, r = nwg % NXCD, xcd = wgid % NXCD, off = wgid / NXCD; wgid = (xcd < r ? xcd * (q + 1) : r * (q + 1) + (xcd - r) * q) + off; }
            const int nig = WGM * nN, gid = wgid / nig, fm = gid * WGM, gsz = (nM - fm) < WGM ? (nM - fm) : WGM;
            pm = fm + ((wgid % nig) % gsz); pn = (wgid % nig) / gsz; kt0 = 0;
        }
        u.pm = pm; u.pn = pn; u.kt0 = kt0; return ok;
    }
    __device__ __forceinline__ void a_ready(const Unit&) const {}
    __device__ __forceinline__ void done(const Unit&) const {}
};

__device__ __forceinline__ unsigned cvt_pk_bf16(float lo, float hi) { unsigned r; asm volatile("v_cvt_pk_bf16_f32 %0, %1, %2" : "=v"(r) : "v"(lo), "v"(hi)); return r; }
typedef float f32x2 __attribute__((ext_vector_type(2)));

#define PG8_GAS __attribute__((address_space(1)))
struct EpiF32 {
    static constexpr bool PERM = true, AFTER_DRAIN = false;
    float* O; int ldc; const float* res_; float alpha; int split_cols; size_t split_stride; int nkt; size_t kplane;
    __device__ __forceinline__ void operator()(const f32x4 (&acc)[2][2][4][2], const Unit& u, int wr, int wc, int fr, int fq) const {
        const int row0 = u.pm * BM + wr * 64 + fr; int colt = u.pn * BM; float* base = O; const float* res = res_;
        if (nkt) { const int sp = u.kt0 / nkt; base += (size_t)sp * kplane; if (sp) res = nullptr; }
        if (split_cols) { const int t = colt / split_cols; base += (size_t)t * split_stride; colt -= t * split_cols; }
        const int col0 = colt + wc * 32 + 8 * fq;
#pragma unroll
        for (int ai = 0; ai < 2; ++ai)
#pragma unroll
            for (int m = 0; m < 4; ++m) {
                const size_t ro = (size_t)(row0 + ai * HALF + m * 16) * ldc + col0;
#pragma unroll
                for (int bj = 0; bj < 2; ++bj) {
                    f32x4 v0 = acc[ai][bj][m][0], v1 = acc[ai][bj][m][1];
                    if (res) { const f32x4 r0 = *(const PG8_GAS f32x4*)(res + ro + bj * HALF), r1 = *(const PG8_GAS f32x4*)(res + ro + bj * HALF + 4); v0 += r0 * alpha; v1 += r1 * alpha; }
                    *(PG8_GAS f32x4*)(base + ro + bj * HALF) = v0; *(PG8_GAS f32x4*)(base + ro + bj * HALF + 4) = v1;
                }
            }
    }
};
struct EpiSwiGLU {
    static constexpr bool PERM = true, AFTER_DRAIN = false;
    bf16_t* H; int ldh;
    __device__ __forceinline__ void operator()(const f32x4 (&acc)[2][2][4][2], const Unit& u, int wr, int wc, int fr, int fq) const {
        const int row0 = u.pm * BM + wr * 64 + fr; const int hc0 = u.pn * 128 + wc * 16 + 4 * fq;
#pragma unroll
        for (int ai = 0; ai < 2; ++ai)
#pragma unroll
            for (int m = 0; m < 4; ++m) {
                bf16_t* rowp = H + (size_t)(row0 + ai * HALF + m * 16) * ldh + hc0;
#pragma unroll
                for (int bj = 0; bj < 2; ++bj) {
                    const f32x4 g = acc[ai][bj][m][0], up = acc[ai][bj][m][1]; float h[4];
#pragma unroll
                    for (int e = 0; e < 4; ++e) h[e] = g[e] * __builtin_amdgcn_rcpf(1.0f + __expf(-g[e])) * up[e];
                    typedef unsigned u32x2v __attribute__((ext_vector_type(2)));
                    u32x2v w; w.x = cvt_pk_bf16(h[0], h[1]); w.y = cvt_pk_bf16(h[2], h[3]);
                    *(PG8_GAS u32x2v*)(rowp + bj * 64) = w;
                }
            }
    }
};

struct EpiAtomic {
    float* O; int ldc;
    __device__ __forceinline__ void operator()(const f32x4 (&acc)[2][2][4][2], const Unit& u, int wr, int wc, int fr, int fq) const {
        const int row0 = u.pm * BM + wr * 64 + fr; const int col0 = u.pn * BM + wc * 32 + 8 * fq;
#pragma unroll
        for (int ai = 0; ai < 2; ++ai)
#pragma unroll
            for (int m = 0; m < 4; ++m) {
                PG8_GAS float* rp = (PG8_GAS float*)(O + (size_t)(row0 + ai * HALF + m * 16) * ldc + col0);
#pragma unroll
                for (int bj = 0; bj < 2; ++bj)
#pragma unroll
                    for (int n = 0; n < 2; ++n)
#pragma unroll
                        for (int e = 0; e < 4; ++e) __hip_atomic_fetch_add(rp + bj * HALF + 4 * n + e, acc[ai][bj][m][n][e], __ATOMIC_RELAXED, __HIP_MEMORY_SCOPE_AGENT);
            }
    }
};
struct EpiBf16 {
    bf16_t* O; int ld;
    __device__ __forceinline__ void operator()(const f32x4 (&acc)[2][2][4][2], const Unit& u, int wr, int wc, int fr, int fq) const {
        const int row0 = u.pm * BM + wr * 64 + fr; const int col0 = u.pn * BM + wc * 32 + 8 * fq;
#pragma unroll
        for (int ai = 0; ai < 2; ++ai)
#pragma unroll
            for (int m = 0; m < 4; ++m) {
                bf16_t* rowp = O + (size_t)(row0 + ai * HALF + m * 16) * ld + col0;
#pragma unroll
                for (int bj = 0; bj < 2; ++bj) { const f32x4 v0 = acc[ai][bj][m][0], v1 = acc[ai][bj][m][1];
                    u32x4 w; w.x = cvt_pk_bf16(v0[0], v0[1]); w.y = cvt_pk_bf16(v0[2], v0[3]); w.z = cvt_pk_bf16(v1[0], v1[1]); w.w = cvt_pk_bf16(v1[2], v1[3]);
                    *(PG8_GAS u32x4*)(rowp + bj * HALF) = w; }
            }
    }
};
struct EpiBf16Res {
    bf16_t* O; int ld; const float* res; float alpha;
    __device__ __forceinline__ void operator()(const f32x4 (&acc)[2][2][4][2], const Unit& u, int wr, int wc, int fr, int fq) const {
        const int row0 = u.pm * BM + wr * 64 + fr; const int col0 = u.pn * BM + wc * 32 + 8 * fq;
#pragma unroll
        for (int ai = 0; ai < 2; ++ai)
#pragma unroll
            for (int m = 0; m < 4; ++m) {
                const size_t ro = (size_t)(row0 + ai * HALF + m * 16) * ld + col0;
#pragma unroll
                for (int bj = 0; bj < 2; ++bj) {
                    const f32x4 r0 = *(const PG8_GAS f32x4*)(res + ro + bj * HALF), r1 = *(const PG8_GAS f32x4*)(res + ro + bj * HALF + 4);
                    const f32x4 v0 = acc[ai][bj][m][0] + r0 * alpha, v1 = acc[ai][bj][m][1] + r1 * alpha;
                    u32x4 w; w.x = cvt_pk_bf16(v0[0], v0[1]); w.y = cvt_pk_bf16(v0[2], v0[3]); w.z = cvt_pk_bf16(v1[0], v1[1]); w.w = cvt_pk_bf16(v1[2], v1[3]);
                    *(PG8_GAS u32x4*)(O + ro + bj * HALF) = w; }
            }
    }
};
struct EpiGen {
    static constexpr bool PERM = true, AFTER_DRAIN = false;
    int mode; float* O; int ldc; const float* res; float alpha; int split_cols; size_t split_stride; bf16_t* H; int ldh; int nkt; size_t kplane;
    __device__ __forceinline__ void operator()(const f32x4 (&acc)[2][2][4][2], const Unit& u, int wr, int wc, int fr, int fq) const {
        if (mode == 0) { EpiF32 e{O, ldc, res, alpha, split_cols, split_stride, nkt, kplane}; e(acc, u, wr, wc, fr, fq); }
        else if (mode == 1) { EpiSwiGLU e{H, ldh}; e(acc, u, wr, wc, fr, fq); }
        else if (mode == 3) { EpiBf16 e{H, ldh}; e(acc, u, wr, wc, fr, fq); }
        else if (mode == 4) { EpiBf16Res e{H, ldh, res, alpha}; e(acc, u, wr, wc, fr, fq); }
        else { EpiAtomic e{O, ldc}; e(acc, u, wr, wc, fr, fq); }
    }
};
template <class Epi, class Sched, bool ALIGN_EPI = false, bool SP2 = false>
__device__ __forceinline__ void gemm_phase(PG8_LAS unsigned char* lds, const Gemm g, const Sched& S, const Epi& E) {
    int tid_ = threadIdx.x; asm volatile("" : "+v"(tid_));
    const int tid = tid_, wid = __builtin_amdgcn_readfirstlane(tid >> 6), lane = tid & 63, wr = wid >> 2, wc = wid & 3, fr = lane & 15, fq = lane >> 4;
    const int K = g.K, nt = g.nt;
    unsigned voffA[2], voffB[2];
#pragma unroll
    for (int i = 0; i < 2; ++i) { int R, C; stage_rc(tid * 16 + i * 8192, R, C); const int Rb = Epi::PERM ? ((R & ~31) + perm32(R & 31)) : R;
        voffA[i] = (unsigned)(R * K + C) * 2u; voffB[i] = (unsigned)(Rb * K + C) * 2u; }
    const size_t kstep = (size_t)(BK * 2);
    const size_t hstep = (size_t)HALF * K * 2;
    const size_t tstep = 2 * hstep;
    const unsigned ldsw = (unsigned)wid * 1024u;
    const int aoff = lds_byte(wr * 64 + fr, fq * 8), boff = lds_byte(wc * 32 + fr, fq * 8);
#define PG8_SA(b, h) (((b) * 2 + (h)) * HTB)
#define PG8_SB(b, h) ((4 + (b) * 2 + (h)) * HTB)
#define PG8_STAGE(bufoff, gbase, voff) do { _Pragma("unroll") for (int _i = 0; _i < 2; ++_i) \
        __builtin_amdgcn_global_load_lds((const unsigned*)((const char*)(gbase) + (voff)[_i]), (PG8_LAS unsigned*)(lds + (bufoff) + ldsw + _i * 8192), 16, 0, 0); } while (0)
#define PG8_LDA(dst, b, h) do { _Pragma("unroll") for (int m = 0; m < 4; ++m) _Pragma("unroll") for (int k = 0; k < 2; ++k) dst[m][k] = *(const PG8_LAS bf16x8*)(lds + PG8_SA(b, h) + aoff + m * 2048 + k * 1024); } while (0)
#define PG8_LDB(dst, b, h) do { _Pragma("unroll") for (int n = 0; n < 2; ++n) _Pragma("unroll") for (int k = 0; k < 2; ++k) dst[n][k] = *(const PG8_LAS bf16x8*)(lds + PG8_SB(b, h) + boff + n * 2048 + k * 1024); } while (0)
#define PG8_MMA(ai, bj, At, Bt) do { __builtin_amdgcn_s_setprio(1); _Pragma("unroll") for (int m = 0; m < 4; ++m) _Pragma("unroll") for (int n = 0; n < 2; ++n) _Pragma("unroll") for (int k = 0; k < 2; ++k) \
        acc[ai][bj][m][n] = __builtin_amdgcn_mfma_f32_16x16x32_bf16(Bt[n][k], At[m][k], acc[ai][bj][m][n], 0, 0, 0); __builtin_amdgcn_s_setprio(0); } while (0)
#define PG8_WAIT_V(n) asm volatile("s_waitcnt vmcnt(" #n ")" ::: "memory")
#define PG8_WAIT_L(n) asm volatile("s_waitcnt lgkmcnt(" #n ")" ::: "memory")
#define PG8_BAR __builtin_amdgcn_s_barrier()
#define PG8_SCHED __builtin_amdgcn_sched_barrier(0)
    Unit cur, nxt; int ui = 0;
    if (!S.next(0, cur)) return;
    f32x4 acc[2][2][4][2];
#pragma unroll
    for (int a = 0; a < 2; ++a)
#pragma unroll
        for (int b = 0; b < 2; ++b)
#pragma unroll
            for (int m = 0; m < 4; ++m)
#pragma unroll
                for (int n = 0; n < 2; ++n) acc[a][b][m][n] = (f32x4){0.f, 0.f, 0.f, 0.f};
    bf16x8 At[4][2], B0[2][2], B1[2][2];
    const char* cA = (const char*)g.A + (size_t)cur.pm * tstep + (size_t)cur.kt0 * kstep; const char* cB = (const char*)g.Bt + (size_t)cur.pn * tstep + (size_t)cur.kt0 * kstep;
    S.a_ready(cur);
    if constexpr (SP2) {
        PG8_STAGE(PG8_SB(0, 0), cB, voffB); PG8_STAGE(PG8_SB(0, 1), cB + hstep, voffB); PG8_STAGE(PG8_SA(0, 0), cA, voffA); PG8_STAGE(PG8_SA(0, 1), cA + hstep, voffA);
        if (wr == 1) PG8_BAR;
        PG8_WAIT_V(2); PG8_BAR;
        PG8_STAGE(PG8_SB(1, 0), cB + kstep, voffB); PG8_STAGE(PG8_SA(1, 0), cA + kstep, voffA); PG8_STAGE(PG8_SB(1, 1), cB + hstep + kstep, voffB);
        PG8_WAIT_V(6); PG8_BAR;
    } else {
        PG8_STAGE(PG8_SB(0, 0), cB, voffB); PG8_STAGE(PG8_SA(0, 0), cA, voffA); PG8_STAGE(PG8_SB(0, 1), cB + hstep, voffB); PG8_STAGE(PG8_SA(0, 1), cA + hstep, voffA);
        if (wr == 1) PG8_BAR;
        PG8_WAIT_V(4); PG8_BAR;
        PG8_STAGE(PG8_SB(1, 0), cB + kstep, voffB); PG8_STAGE(PG8_SA(1, 0), cA + kstep, voffA); PG8_STAGE(PG8_SB(1, 1), cB + hstep + kstep, voffB);
        PG8_WAIT_V(6); PG8_BAR;
    }
    for (;;) {
        const bool has_next = S.next(ui + 1, nxt);
        const char* nA = has_next ? (const char*)g.A + (size_t)nxt.pm * tstep + (size_t)nxt.kt0 * kstep : cA; const char* nB = has_next ? (const char*)g.Bt + (size_t)nxt.pn * tstep + (size_t)nxt.kt0 * kstep : cB;
        for (int t = 0; t < nt; t += 2) {
            const bool last = (t == nt - 2);
            const char* a1 = cA + (size_t)(t + 1) * kstep;
            const char* a2 = last ? nA : cA + (size_t)(t + 2) * kstep; const char* b2 = last ? nB : cB + (size_t)(t + 2) * kstep;
            const char* a3 = a2 + kstep; const char* b3 = b2 + kstep;
            if (last && has_next) S.a_ready(nxt);
            if constexpr (SP2) {
            PG8_LDB(B0, 0, 0); PG8_LDB(B1, 0, 1); PG8_SCHED; PG8_LDA(At, 0, 0); PG8_STAGE(PG8_SA(1, 1), a1 + hstep, voffA);
            PG8_WAIT_V(8); PG8_WAIT_L(0); PG8_BAR; PG8_MMA(0, 0, At, B0); PG8_MMA(0, 1, At, B1); PG8_BAR; PG8_SCHED;
            PG8_LDA(At, 0, 1); PG8_STAGE(PG8_SB(0, 0), b2, voffB); PG8_STAGE(PG8_SB(0, 1), b2 + hstep, voffB); PG8_STAGE(PG8_SA(0, 0), a2, voffA);
            PG8_WAIT_V(8); PG8_WAIT_L(0); PG8_BAR; PG8_MMA(1, 0, At, B0); PG8_MMA(1, 1, At, B1); PG8_BAR; PG8_SCHED;
            PG8_LDB(B0, 1, 0); PG8_LDB(B1, 1, 1); PG8_SCHED; PG8_LDA(At, 1, 0); PG8_STAGE(PG8_SA(0, 1), a2 + hstep, voffA);
            PG8_WAIT_V(8); PG8_WAIT_L(0); PG8_BAR; PG8_MMA(0, 0, At, B0); PG8_MMA(0, 1, At, B1); PG8_BAR; PG8_SCHED;
            PG8_LDA(At, 1, 1); PG8_STAGE(PG8_SB(1, 0), b3, voffB); PG8_STAGE(PG8_SB(1, 1), b3 + hstep, voffB); PG8_STAGE(PG8_SA(1, 0), a3, voffA);
            PG8_WAIT_V(8); PG8_WAIT_L(0); PG8_BAR; PG8_MMA(1, 0, At, B0); PG8_MMA(1, 1, At, B1); PG8_BAR; PG8_SCHED;
            } else {
            PG8_LDB(B0, 0, 0); PG8_SCHED; PG8_LDA(At, 0, 0); PG8_STAGE(PG8_SA(1, 1), a1 + hstep, voffA);
            PG8_WAIT_L(8); PG8_BAR; PG8_WAIT_L(0); PG8_MMA(0, 0, At, B0); PG8_BAR; PG8_SCHED;
            PG8_LDB(B1, 0, 1); PG8_STAGE(PG8_SB(0, 0), b2, voffB);
            PG8_BAR; PG8_WAIT_L(0); PG8_MMA(0, 1, At, B1); PG8_BAR;
            PG8_LDA(At, 0, 1); PG8_STAGE(PG8_SA(0, 0), a2, voffA);
            PG8_BAR; PG8_WAIT_L(0); PG8_MMA(1, 0, At, B0); PG8_BAR; PG8_SCHED;
            PG8_STAGE(PG8_SB(0, 1), b2 + hstep, voffB);
            PG8_WAIT_V(6); PG8_BAR; PG8_MMA(1, 1, At, B1); PG8_BAR;
            PG8_LDB(B0, 1, 0); PG8_SCHED; PG8_LDA(At, 1, 0); PG8_STAGE(PG8_SA(0, 1), a2 + hstep, voffA);
            PG8_WAIT_L(8); PG8_BAR; PG8_WAIT_L(0); PG8_MMA(0, 0, At, B0); PG8_BAR; PG8_SCHED;
            PG8_LDB(B1, 1, 1); PG8_STAGE(PG8_SB(1, 0), b3, voffB);
            PG8_BAR; PG8_WAIT_L(0); PG8_MMA(0, 1, At, B1); PG8_BAR;
            PG8_LDA(At, 1, 1); PG8_STAGE(PG8_SA(1, 0), a3, voffA);
            PG8_BAR; PG8_WAIT_L(0); PG8_MMA(1, 0, At, B0); PG8_BAR; PG8_SCHED;
            PG8_STAGE(PG8_SB(1, 1), b3 + hstep, voffB);
            PG8_WAIT_V(6); PG8_BAR; PG8_MMA(1, 1, At, B1); PG8_BAR;
            }
        }
        if constexpr (ALIGN_EPI) { if (wr == 0) PG8_BAR; }
        if constexpr (!Epi::AFTER_DRAIN) { E(acc, cur, wr, wc, fr, fq); S.done(cur); }
        if (!has_next) break;
#pragma unroll
        for (int a = 0; a < 2; ++a)
#pragma unroll
            for (int b = 0; b < 2; ++b)
#pragma unroll
                for (int m = 0; m < 4; ++m)
#pragma unroll
                    for (int n = 0; n < 2; ++n) acc[a][b][m][n] = (f32x4){0.f, 0.f, 0.f, 0.f};
        cur = nxt; cA = nA; cB = nB; ++ui;
        if constexpr (ALIGN_EPI) { if (wr == 1) PG8_BAR; }
    }
    PG8_WAIT_V(0);
    if constexpr (!ALIGN_EPI) { if (wr == 0) PG8_BAR; }
    PG8_BAR;
    if constexpr (Epi::AFTER_DRAIN) { E.fused(acc, cur, wr, wc, fr, fq, lds, wid, lane); S.done(cur); }
#undef PG8_SA
#undef PG8_SB
#undef PG8_STAGE
#undef PG8_LDA
#undef PG8_LDB
#undef PG8_MMA
#undef PG8_WAIT_V
#undef PG8_WAIT_L
#undef PG8_BAR
#undef PG8_SCHED
}
}

typedef unsigned short bf16;
typedef float f32x4 __attribute__((ext_vector_type(4)));
typedef float f32x2 __attribute__((ext_vector_type(2)));
typedef short bf16x8 __attribute__((ext_vector_type(8)));
typedef unsigned u32x4 __attribute__((ext_vector_type(4)));
typedef unsigned u32x2 __attribute__((ext_vector_type(2)));

constexpr int NWAVES = 8, NTHR = 512;
constexpr int DM = 2048, NPR = 8192, NSM = 512, MROWS = 8704, SEQ = 2048;
constexpr int RWC = 3328, INC = 7440, PLD = 7680, GD0 = 3328;
constexpr int FF = 5632, XAW = 512;
constexpr float ALPHA = 1.41421356237f;
constexpr int LDS_BYTES = 147456;

constexpr size_t O_YP = 0, O_YS = O_YP + (size_t)NPR * DM, O_PRW = O_YS + (size_t)NSM * DM, O_PSH = O_PRW + 2ull * 4 * 16 * 4096,
    O_PGD = O_PSH + 2ull * 4 * RWC, O_PCV = O_PGD + 2ull * 4 * 8 * 16384, O_PMK = O_PCV + 2ull * 4 * 3 * 3072, O_PMV = O_PMK + 2ull * 4 * 256 * 512,
    O_SRW = O_PMV + 2ull * 4 * 256 * 512, O_SSH = O_SRW + 2ull * 128 * 16 * 4096, O_SGD = O_SSH + 2ull * 128 * RWC, O_SCV = O_SGD + 2ull * 128 * 8 * 16384,
    O_END = O_SCV + 2ull * 128 * 3 * 3072;
static_assert(O_END == 75139072ull, "output size");

constexpr size_t MiB = 1u << 20;
constexpr size_t WS_WIN = 1 * MiB, WS_WOUT = WS_WIN + 30 * MiB, WS_WQ = WS_WOUT + 8 * MiB, WS_WKV = WS_WQ + 2 * MiB, WS_WO = WS_WKV + 4 * MiB,
    WS_WGU = WS_WO + 2 * MiB, WS_WD = WS_WGU + 44 * MiB, WS_LORA = WS_WD + 22 * MiB, WS_X = WS_LORA + 1 * MiB, WS_XB = WS_X + 68 * MiB, WS_MEMB = WS_XB + 34 * MiB,
    WS_P = WS_MEMB + 4 * MiB, WS_SC = WS_P + 255 * MiB, WS_END = WS_SC + 442 * MiB;
constexpr size_t WS_PRE = WS_P;
constexpr size_t W1OFF = WS_P + 128 * MiB - WS_WIN;
static_assert(W1OFF + WS_X <= WS_SC, "second weight set inside the P region");
constexpr size_t SCB = 34 * MiB;
constexpr unsigned SCBF = (unsigned)(SCB / 4);
constexpr size_t WS_R = WS_SC, WS_W = WS_R + SCB, WS_K = WS_W + SCB, WS_V = WS_K + SCB, WS_A = WS_V + SCB, WS_B = WS_A + SCB, WS_G = WS_B + SCB,
    WS_QG = WS_G + SCB, WS_KG = WS_QG + SCB, WS_VG = WS_KG + SCB, WS_BG = WS_VG + SCB, WS_ORW = WS_BG + SCB, WS_OGD = WS_ORW + SCB;
static_assert(WS_OGD + SCB <= WS_END, "scan region");
constexpr size_t WS_MIX = WS_W;
constexpr size_t WS_H = WS_A, WS_Q = WS_QG, WS_AO = WS_KG, WS_PART = WS_VG;
static_assert(94 * MiB <= 3 * SCB && 44 * MiB <= 2 * SCB, "overlays");

__device__ __forceinline__ unsigned f2bf(float f) { unsigned u = __builtin_bit_cast(unsigned, f); return (u + 0x7fffu + ((u >> 16) & 1u)) >> 16; }
__device__ __forceinline__ unsigned pk2(float lo, float hi) { return f2bf(lo) | (f2bf(hi) << 16); }
template <int CTRL> __device__ __forceinline__ float dppf(float x) { return __builtin_bit_cast(float, __builtin_amdgcn_mov_dpp(__builtin_bit_cast(int, x), CTRL, 0xf, 0xf, true)); }
__device__ __forceinline__ float reduce16(float v) {
    v += dppf<0xB1>(v); v += dppf<0x4E>(v); v += dppf<0x141>(v); v += dppf<0x128>(v); return v;
}
__device__ __forceinline__ float reduce8(float v) {
    v += dppf<0xB1>(v); v += dppf<0x4E>(v); v += dppf<0x141>(v); return v;
}
__device__ __forceinline__ float wave_sum(float v) {
    v = reduce16(v); const int iv = __builtin_bit_cast(int, v);
    return (__builtin_bit_cast(float, __builtin_amdgcn_readlane(iv, 0)) + __builtin_bit_cast(float, __builtin_amdgcn_readlane(iv, 16))) +
           (__builtin_bit_cast(float, __builtin_amdgcn_readlane(iv, 32)) + __builtin_bit_cast(float, __builtin_amdgcn_readlane(iv, 48)));
}
#define GAS __attribute__((address_space(1)))
#define LAS __attribute__((address_space(3)))
__device__ __forceinline__ f32x4 ldg4(const float* p) { return *(const GAS f32x4*)p; }
__device__ __forceinline__ float ldg1(const float* p) { return *(const GAS float*)p; }
__device__ __forceinline__ void stg4(float* p, f32x4 v) { *(GAS f32x4*)p = v; }
__device__ __forceinline__ void stg1(float* p, float v) { *(GAS float*)p = v; }
__device__ __forceinline__ void stgb(bf16* p, unsigned v) { *(GAS bf16*)p = (bf16)v; }
__device__ __forceinline__ f32x2 lo2(f32x4 a) { return (f32x2){a.x, a.y}; }
__device__ __forceinline__ f32x2 hi2(f32x4 a) { return (f32x2){a.z, a.w}; }
__device__ __forceinline__ f32x4 ldb4(const bf16* p) { const u32x2 w = *(const GAS u32x2*)p;
    return (f32x4){__builtin_bit_cast(float, w.x << 16), __builtin_bit_cast(float, w.x & 0xffff0000u), __builtin_bit_cast(float, w.y << 16), __builtin_bit_cast(float, w.y & 0xffff0000u)}; }
__device__ __forceinline__ float ldb1(const bf16* p) { return __builtin_bit_cast(float, (unsigned)(*(const GAS bf16*)p) << 16); }
__device__ __forceinline__ float dot4(f32x4 a, f32x4 b) { f32x2 p = lo2(a) * lo2(b); p = __builtin_elementwise_fma(hi2(a), hi2(b), p); return p.x + p.y; }
__device__ __forceinline__ float dot8(f32x4 a0, f32x4 a1, f32x4 b0, f32x4 b1) {
    f32x2 p = lo2(a0) * lo2(b0), q = hi2(a0) * hi2(b0); p = __builtin_elementwise_fma(lo2(a1), lo2(b1), p); q = __builtin_elementwise_fma(hi2(a1), hi2(b1), q); p = p + q; return p.x + p.y; }
__device__ __forceinline__ float rcpf_(float x) { return __builtin_amdgcn_rcpf(x); }
__device__ __forceinline__ float rsqf_(float x) { return __builtin_amdgcn_rsqf(x); }
__device__ __forceinline__ float sigmoidf_(float x) { return rcpf_(1.0f + __expf(-x)); }
__device__ __forceinline__ float softplusf_(float x) { return fmaxf(x, 0.f) + __logf(1.0f + __expf(-fabsf(x))); }
__device__ __forceinline__ float tanhf_(float x) { return 1.0f - 2.0f * rcpf_(1.0f + __expf(2.0f * x)); }
#define LDS_WAIT() asm volatile("s_waitcnt lgkmcnt(0)" ::: "memory")

__device__ __forceinline__ void tr_item(const float* __restrict__ W, int K, int N, bf16* __restrict__ WT, int mode, int row_off, float* scr, int item, int lane) {
    const int nblk = (N + 63) >> 6; const int kb = item / nblk, nb = item - kb * nblk; const int k0 = kb * 64, n0 = nb * 64;
    const int kr = lane >> 4, nc = (lane & 15) * 4; const bool nv = n0 + nc < N;
    f32x4 v[16];
#pragma unroll
    for (int j = 0; j < 16; ++j) v[j] = nv ? ldg4(W + (size_t)(k0 + kr + 4 * j) * N + n0 + nc) : (f32x4){0.f, 0.f, 0.f, 0.f};
#pragma unroll
    for (int j = 0; j < 16; ++j) { float* d = scr + (kr + 4 * j) * 65 + nc; d[0] = v[j].x; d[1] = v[j].y; d[2] = v[j].z; d[3] = v[j].w; }
    LDS_WAIT();
    const int c = lane & 7;
#pragma unroll
    for (int j = 0; j < 8; ++j) {
        const int nn = (lane >> 3) + 8 * j; const float* s = scr + (8 * c) * 65 + nn;
        u32x4 o; o.x = pk2(s[0], s[65]); o.y = pk2(s[2 * 65], s[3 * 65]); o.z = pk2(s[4 * 65], s[5 * 65]); o.w = pk2(s[6 * 65], s[7 * 65]);
        const int ng = n0 + nn;
        if (ng < N) {
            const int drow = mode == 0 ? row_off + ng : ((ng >> 2) * 8 + (mode == 2 ? 4 : 0) + (ng & 3));
            *(GAS u32x4*)(WT + (size_t)drow * K + k0 + 8 * c) = o;
        }
    }
    LDS_WAIT();
}

struct Args { const float* in[39]; float* out; unsigned char* ws; int ph_lo, ph_hi; };
struct LayerW {
    const float *w_in, *w_out, *wq, *wk, *wv, *wo, *wg, *wu, *wd, *w2, *a2, *g2;
};
constexpr int CONV_NIT = 32 * 117 + 32 * 32 + 3 * (32 * 8) + 8 * 32 + 2 * (32 * 88) + 88 * 32 + 2 * 16 + 32;
__device__ __forceinline__ void convert_item(const LayerW& L, unsigned char* ws, float* scr, int it, int lane) {
    constexpr int I_IN = 32 * 117, I_OUT = 32 * 32, I_Q = 32 * 8, I_O = 8 * 32, I_G = 32 * 88, I_D = 88 * 32, I_L = 16;
    bf16* lora = (bf16*)(ws + WS_LORA);
    int r = it;
    if (r < I_IN) { tr_item(L.w_in, DM, INC, (bf16*)(ws + WS_WIN), 0, 0, scr, r, lane); return; } r -= I_IN;
    if (r < I_G) { tr_item(L.wg, DM, FF, (bf16*)(ws + WS_WGU), 1, 0, scr, r, lane); return; } r -= I_G;
    if (r < I_G) { tr_item(L.wu, DM, FF, (bf16*)(ws + WS_WGU), 2, 0, scr, r, lane); return; } r -= I_G;
    if (r < I_D) { tr_item(L.wd, FF, DM, (bf16*)(ws + WS_WD), 0, 0, scr, r, lane); return; } r -= I_D;
    if (r < I_OUT) { tr_item(L.w_out, DM, DM, (bf16*)(ws + WS_WOUT), 0, 0, scr, r, lane); return; } r -= I_OUT;
    if (r < I_Q) { tr_item(L.wq, DM, XAW, (bf16*)(ws + WS_WQ), 0, 0, scr, r, lane); return; } r -= I_Q;
    if (r < I_Q) { tr_item(L.wk, DM, XAW, (bf16*)(ws + WS_WKV), 0, 0, scr, r, lane); return; } r -= I_Q;
    if (r < I_Q) { tr_item(L.wv, DM, XAW, (bf16*)(ws + WS_WKV), 0, 512, scr, r, lane); return; } r -= I_Q;
    if (r < I_O) { tr_item(L.wo, XAW, DM, (bf16*)(ws + WS_WO), 0, 0, scr, r, lane); return; } r -= I_O;
    if (r < I_L) { tr_item(L.w2, 64, 1024, lora, 0, 0, scr, r, lane); return; } r -= I_L;
    if (r < I_L) { tr_item(L.a2, 64, 1024, lora + 65536, 0, 0, scr, r, lane); return; } r -= I_L;
    tr_item(L.g2, 128, 1024, lora + 131072, 0, 0, scr, r, lane);
}
__device__ __forceinline__ void convert_weights(const LayerW& L, unsigned char* ws, float* scr, int gw, int NGW, int lane) {
    for (int it = gw; it < CONV_NIT; it += NGW) convert_item(L, ws, scr, it, lane);
}
__device__ __forceinline__ void row_copy_cvt(const float* src, float* dstf, bf16* dstb, int lane) {
#pragma unroll
    for (int j = 0; j < 8; ++j) {
        const f32x4 v = ldg4(src + 4 * (lane + 64 * j));
        if (dstf) stg4(dstf + 4 * (lane + 64 * j), v);
        u32x2 w; w.x = pk2(v.x, v.y); w.y = pk2(v.z, v.w);
        *((GAS u32x2*)dstb + lane + 64 * j) = w;
    }
}
__device__ __forceinline__ void ln_row(const float* src, const bf16* srcb, int nparts, const float* g, const float* b, float* dstf, bf16* dstb, int lane) {
    f32x4 v[8]; float s = 0.f;
#pragma unroll
    for (int j = 0; j < 8; ++j) v[j] = srcb ? ldb4(srcb + 4 * (lane + 64 * j)) : ldg4(src + 4 * (lane + 64 * j));
    for (int p = 1; p < nparts; ++p) {
#pragma unroll
        for (int j = 0; j < 8; ++j) v[j] += ldg4(src + (size_t)p * (NSM * DM) + 4 * (lane + 64 * j));
    }
#pragma unroll
    for (int j = 0; j < 8; ++j) s += (v[j].x + v[j].y) + (v[j].z + v[j].w);
    const float mean = wave_sum(s) * (1.f / DM); float s2 = 0.f;
#pragma unroll
    for (int j = 0; j < 8; ++j) { v[j] = v[j] - mean; s2 += (v[j].x * v[j].x + v[j].y * v[j].y) + (v[j].z * v[j].z + v[j].w * v[j].w); }
    const float rstd = rsqf_(wave_sum(s2) * (1.f / DM) + 1e-5f);
#pragma unroll
    for (int j = 0; j < 8; ++j) {
        const f32x4 gg = ldg4(g + 4 * (lane + 64 * j)), bb = ldg4(b + 4 * (lane + 64 * j));
        const f32x4 y = v[j] * rstd * gg + bb;
        stg4(dstf + 4 * (lane + 64 * j), y);
        if (dstb) { u32x2 w; w.x = pk2(y.x, y.y); w.y = pk2(y.z, y.w); *((GAS u32x2*)dstb + lane + 64 * j) = w; }
    }
}

struct PrepArgs {
    const bf16* P; const float* state_shift; const float* state_conv;
    const float *mu, *w0, *a0, *kkw, *kaw, *convw, *alog, *dtb;
    const bf16 *W2t, *A2t, *G2t;
    float *R, *W, *K, *V, *A, *B, *G, *QG, *KG, *VG, *BETA, *GDEC;
    float *o_psh, *o_pcv, *o_ssh, *o_scv;
};
__device__ __forceinline__ void prep_rw_unit(const PrepArgs& a, LAS unsigned char* lds, int unit, int tid, int wave, int lane) {
    LAS bf16* A2 = (LAS bf16*)lds;
    LAS float* LL = (LAS float*)(lds + 32 * 264 * 2);
    const int item = unit >> 2, hq = unit & 3; const int m0 = item * 32;
    const int quad = lane >> 4, l15 = lane & 15;
    {
        const int tk = tid >> 4, c0 = (tid & 15) * 16; const int m = m0 + tk;
        const bf16* prow = a.P + (size_t)m * PLD + 3072 + c0;
        const bf16* pprev = prow - PLD; const float* sprev = nullptr; float pm = 1.f;
        if (m < NPR) { if (!(m & (SEQ - 1))) { pprev = prow; pm = 0.f; } }
        else { const int j = m - NPR; if (!(j & 3)) sprev = a.state_shift + (size_t)(j >> 2) * RWC + 3072 + c0; }
        unsigned pk[8];
#pragma unroll
        for (int q4 = 0; q4 < 4; ++q4) {
            const f32x4 p = ldb4(prow + 4 * q4); const f32x4 pv = sprev ? ldg4(sprev + 4 * q4) : ldb4(pprev + 4 * q4) * pm;
            const f32x4 mu = ldg4(a.mu + 3072 + c0 + 4 * q4);
            f32x4 x = p + (pv - p) * mu;
            const int cc = c0 + 4 * q4;
            if (cc < 64) { x.x = tanhf_(x.x); x.y = tanhf_(x.y); x.z = tanhf_(x.z); x.w = tanhf_(x.w); }
            else if (cc >= 128) { x.x = sigmoidf_(x.x); x.y = sigmoidf_(x.y); x.z = sigmoidf_(x.z); x.w = sigmoidf_(x.w); }
            pk[2 * q4] = pk2(x.x, x.y); pk[2 * q4 + 1] = pk2(x.z, x.w);
        }
        LAS u32x4* d = (LAS u32x4*)(A2 + tk * 264 + c0);
        d[0] = (u32x4){pk[0], pk[1], pk[2], pk[3]}; d[1] = (u32x4){pk[4], pk[5], pk[6], pk[7]};
    }
    __syncthreads();
    const int mt = wave & 1, nt = wave >> 1;
    const LAS bf16* arow = A2 + (mt * 16 + l15) * 264 + quad * 8;
    {
        const int h0 = hq * 4;
#pragma unroll
        for (int hh = 0; hh < 4; ++hh) {
            const int n = (h0 + hh) * 64 + nt * 16 + l15;
            f32x4 cw = {0.f, 0.f, 0.f, 0.f}, ca = cw, cg = cw;
#pragma unroll
            for (int ks = 0; ks < 2; ++ks) {
                const bf16x8 av = *(const LAS bf16x8*)(arow + 32 * ks), bv = *(const GAS bf16x8*)(a.W2t + n * 64 + 32 * ks + quad * 8);
                cw = __builtin_amdgcn_mfma_f32_16x16x32_bf16(av, bv, cw, 0, 0, 0);
                const bf16x8 av2 = *(const LAS bf16x8*)(arow + 64 + 32 * ks), bv2 = *(const GAS bf16x8*)(a.A2t + n * 64 + 32 * ks + quad * 8);
                ca = __builtin_amdgcn_mfma_f32_16x16x32_bf16(av2, bv2, ca, 0, 0, 0);
            }
#pragma unroll
            for (int ks = 0; ks < 4; ++ks) {
                const bf16x8 av = *(const LAS bf16x8*)(arow + 128 + 32 * ks), bv = *(const GAS bf16x8*)(a.G2t + n * 128 + 32 * ks + quad * 8);
                cg = __builtin_amdgcn_mfma_f32_16x16x32_bf16(av, bv, cg, 0, 0, 0);
            }
#pragma unroll
            for (int j = 0; j < 4; ++j) {
                const int o = hh * (3 * 32 * 68) + (mt * 16 + quad * 4 + j) * 68 + nt * 16 + l15;
                LL[o] = cw[j]; LL[32 * 68 + o] = ca[j]; LL[2 * 32 * 68 + o] = cg[j];
            }
        }
        __syncthreads();
        {
            const int tk = wave * 4 + (lane >> 4); const int m = m0 + tk;
            const bf16* prow = a.P + (size_t)m * PLD;
            const bf16* pprev = prow - PLD; const float* sprev = nullptr; float pm = 1.f;
            if (m < NPR) { if (!(m & (SEQ - 1))) { pprev = prow; pm = 0.f; } }
            else { const int j = m - NPR; if (!(j & 3)) sprev = a.state_shift + (size_t)(j >> 2) * RWC; }
            f32x4 pr[4], pk_[4], pv[4], qr[4], qk[4], qv[4];
#pragma unroll
            for (int hh = 0; hh < 4; ++hh) { const int col = (h0 + hh) * 64 + 4 * l15;
                pr[hh] = ldb4(prow + col); pk_[hh] = ldb4(prow + 1024 + col); pv[hh] = ldb4(prow + 2048 + col);
                if (sprev) { qr[hh] = ldg4(sprev + col); qk[hh] = ldg4(sprev + 1024 + col); qv[hh] = ldg4(sprev + 2048 + col); }
                else { qr[hh] = ldb4(pprev + col) * pm; qk[hh] = ldb4(pprev + 1024 + col) * pm; qv[hh] = ldb4(pprev + 2048 + col) * pm; } }
#pragma unroll
            for (int hh = 0; hh < 4; ++hh) {
                const int col = (h0 + hh) * 64 + 4 * l15;
                const f32x4 mur = ldg4(a.mu + col), muk = ldg4(a.mu + 1024 + col), muv = ldg4(a.mu + 2048 + col);
                const f32x4 w0 = ldg4(a.w0 + col), a0 = ldg4(a.a0 + col), kkw = ldg4(a.kkw + col), kaw = ldg4(a.kaw + col);
                const LAS float* L0 = LL + hh * (3 * 32 * 68) + tk * 68 + 4 * l15;
                const f32x4 lw4 = *(const LAS f32x4*)L0, la4 = *(const LAS f32x4*)(L0 + 32 * 68), g4 = *(const LAS f32x4*)(L0 + 2 * 32 * 68);
                const f32x4 r4 = pr[hh] + (qr[hh] - pr[hh]) * mur, k4 = pk_[hh] + (qk[hh] - pk_[hh]) * muk, v4 = pv[hh] + (qv[hh] - pv[hh]) * muv;
                const f32x4 kkv = k4 * kkw;
                const float n2 = reduce16(dot4(kkv, kkv)); const float rn = rsqf_(n2 + 1e-12f);
                f32x4 dec, k2, am, bm;
#pragma unroll
                for (int e = 0; e < 4; ++e) {
                    const float lw = lw4[e] + w0[e];
                    const float wlog = -softplusf_(-lw) - 0.5f;
                    dec[e] = __expf(-__expf(wlog));
                    const float av = sigmoidf_(a0[e] + la4[e]);
                    const float kk = kkv[e] * rn;
                    k2[e] = k4[e] * (1.0f + (av - 1.0f) * kaw[e]);
                    am[e] = -kk; bm[e] = kk * av;
                }
                const size_t o = (size_t)m * 1024 + col;
                stg4(a.R + o, r4); stg4(a.W + o, dec); stg4(a.K + o, k2); stg4(a.V + o, v4); stg4(a.A + o, am); stg4(a.B + o, bm); stg4(a.G + o, g4);
            }
        }
        __syncthreads();
    }
}
__device__ __forceinline__ void prep_gd_pair(const PrepArgs& a, int q, int lane) {
    const int m = q >> 2, hp = q & 3; const int h = 2 * hp + (lane >> 5), c4 = 4 * (lane & 31);
    int t, sbase; const float* cprev;
    if (m < NPR) { t = m & (SEQ - 1); sbase = m - t; cprev = nullptr; }
    else { const int j = m - NPR; t = j & 3; sbase = m - t; cprev = a.state_conv + (size_t)(j >> 2) * 3 * 3072; }
    f32x4 acc[3];
#pragma unroll
    for (int s3 = 0; s3 < 3; ++s3) acc[s3] = (f32x4){0.f, 0.f, 0.f, 0.f};
#pragma unroll
    for (int j = 0; j < 4; ++j) {
        const int xi = t + j; const bf16* src = a.P + (size_t)m * PLD + GD0; const float* fsrc = nullptr; float fm = 1.f;
        if (xi >= 3) src = a.P + (size_t)(sbase + xi - 3) * PLD + GD0;
        else if (cprev) fsrc = cprev + (size_t)xi * 3072;
        else fm = 0.f;
#pragma unroll
        for (int s3 = 0; s3 < 3; ++s3) { const int cc = s3 * 1024 + h * 128 + c4; const f32x4 x = fsrc ? ldg4(fsrc + cc) : ldb4(src + cc) * fm; acc[s3] += x * ldg4(a.convw + j * 3072 + cc); }
    }
#pragma unroll
    for (int s3 = 0; s3 < 3; ++s3)
#pragma unroll
        for (int e = 0; e < 4; ++e) { const float x = acc[s3][e]; acc[s3][e] = x * sigmoidf_(x); }
    float qn = reduce16(dot4(acc[0], acc[0])), kn = reduce16(dot4(acc[1], acc[1]));
    qn += __shfl_xor(qn, 16); kn += __shfl_xor(kn, 16);
    const float qs = rsqf_(qn + 1e-12f) * 0.08838834764831845f, ks = rsqf_(kn + 1e-12f);
    const size_t o = (size_t)m * 1024 + h * 128 + c4;
    stg4(a.QG + o, acc[0] * qs); stg4(a.KG + o, acc[1] * ks); stg4(a.VG + o, acc[2]);
    if ((lane & 31) == 0) {
        const float braw = ldb1(a.P + (size_t)m * PLD + GD0 + 4096 + h), araw = ldb1(a.P + (size_t)m * PLD + GD0 + 4104 + h);
        stg1(a.BETA + (size_t)m * 1024 + h * 2, sigmoidf_(braw));
        stg1(a.BETA + (size_t)m * 1024 + h * 2 + 1, __expf(-__expf(ldg1(a.alog + h)) * softplusf_(araw + ldg1(a.dtb + h))));
    }
}
__device__ __forceinline__ void prep_copy_unit(const PrepArgs& a, int u, int lane) {
    const bf16* src; float* dst; int n4;
    if (u < 396) { const int seq = u / 3, i = u - seq * 3; n4 = 768;
        if (seq < 4) { src = a.P + (size_t)(seq * SEQ + SEQ - 3 + i) * PLD + GD0; dst = a.o_pcv + (size_t)(seq * 3 + i) * 3072; }
        else { const int b = seq - 4; src = a.P + (size_t)(NPR + 4 * b + 1 + i) * PLD + GD0; dst = a.o_scv + (size_t)(b * 3 + i) * 3072; } }
    else { const int v = u - 396; n4 = 832;
        if (v < 4) { src = a.P + (size_t)(v * SEQ + SEQ - 1) * PLD; dst = a.o_psh + (size_t)v * RWC; }
        else { const int b = v - 4; src = a.P + (size_t)(NPR + 4 * b + 3) * PLD; dst = a.o_ssh + (size_t)b * RWC; } }
    for (int c = lane; c < n4; c += 64) stg4(dst + 4 * c, ldb4(src + 4 * c));
}

struct ScanArgs {
    const float *R, *W, *K, *V, *A, *B, *QG, *KG, *VG, *BETA, *GDEC;
    const float *st_rw, *st_gd;
    float *ORW, *OGD;
    float *o_prw, *o_pgd, *o_srw, *o_sgd;
};
constexpr int TC = 16, RW_STEP = 336, GD_STEP = 276, SC_BUF = TC * (RW_STEP + GD_STEP);
__device__ __forceinline__ unsigned sc_slot(bool rw, int i, int t2, int m0, int h, int part) {
    const int idx = t2 + 256 * i; unsigned eo = 0u;
    if (rw) {
        if (idx < TC * 84) {
            const int stp = idx / 84, f4 = idx - stp * 84; const int vec = f4 >> 4, o4 = (f4 & 15) * 4;
            const unsigned arr = vec == 0 ? 1u : vec == 1 ? 4u : vec == 2 ? 5u : vec == 3 ? 2u : vec == 4 ? 0u : 3u;
            eo = arr * SCBF + (unsigned)(m0 + stp) * 1024u + h * 64 + (vec == 5 ? part * 16 + o4 : o4);
        }
    } else {
        if (i < 5 && idx < TC * 69) {
            const int stp = idx / 69, f4 = idx - stp * 69; const unsigned rb = (unsigned)(m0 + stp) * 1024u;
            if (f4 < 32) eo = 8u * SCBF + rb + h * 128 + f4 * 4;
            else if (f4 < 64) eo = 7u * SCBF + rb + h * 128 + (f4 - 32) * 4;
            else if (f4 < 68) eo = 9u * SCBF + rb + h * 128 + part * 16 + (f4 - 64) * 4;
            else eo = 10u * SCBF + rb + h * 2;
        }
    }
    return eo * 4u;
}
__device__ __forceinline__ f32x4 sc_load(const float* base, unsigned boff, int c) {
    return *(const GAS f32x4*)((const GAS char*)base + (boff + (unsigned)c * (TC * 1024u * 4u)));
}
__device__ __forceinline__ void sc_store(LAS float* bf, bool rw, int i, int t2, f32x4 v) {
    const int idx = t2 + 256 * i;
    if (rw) { if (idx < TC * 84) { const int stp = idx / 84, f4 = idx - stp * 84; *(LAS f32x4*)(bf + stp * RW_STEP + f4 * 4) = v; } }
    else { if (i < 5 && idx < TC * 69) { const int stp = idx / 69, f4 = idx - stp * 69; *(LAS f32x4*)(bf + TC * RW_STEP + stp * GD_STEP + f4 * 4) = v; } }
}
template <int NI> __device__ __forceinline__ void scan_sample_rw(const ScanArgs& a, int q, int lane) {
    const int grp16 = lane >> 4, l15 = lane & 15, ks = l15 * 4;
    f32x4 s[NI], w[NI][4], av[NI][4], bv[NI][4], kv[NI][4], rv[NI][4]; float vv[NI][4]; size_t so[NI]; int m0[NI], oc[NI];
#pragma unroll
    for (int ii = 0; ii < NI; ++ii) {
        const int j = NI * q + ii; const int bh = j >> 4, g = j & 15; const int b = bh >> 4, h = bh & 15; const int row = 4 * g + grp16;
        m0[ii] = NPR + 4 * b; oc[ii] = h * 64 + row; so[ii] = (size_t)bh * 4096 + row * 64 + ks;
        s[ii] = ldg4(a.st_rw + so[ii]);
#pragma unroll
        for (int t = 0; t < 4; ++t) { const size_t o = (size_t)(m0[ii] + t) * 1024 + h * 64;
            w[ii][t] = ldg4(a.W + o + ks); av[ii][t] = ldg4(a.A + o + ks); bv[ii][t] = ldg4(a.B + o + ks); kv[ii][t] = ldg4(a.K + o + ks); rv[ii][t] = ldg4(a.R + o + ks); vv[ii][t] = ldg1(a.V + o + row); }
    }
#pragma unroll
    for (int ii = 0; ii < NI; ++ii) {
        float osave = 0.f;
#pragma unroll
        for (int t = 0; t < 4; ++t) {
            const float sa = reduce16(dot4(s[ii], av[ii][t]));
            s[ii] = s[ii] * w[ii][t] + (bv[ii][t] * sa + kv[ii][t] * vv[ii][t]);
            const float o = reduce16(dot4(s[ii], rv[ii][t]));
            osave = (l15 == t) ? o : osave;
        }
        if (l15 < 4) stg1(a.ORW + (size_t)(m0[ii] + l15) * 1024 + oc[ii], osave);
        stg4(a.o_srw + so[ii], s[ii]);
    }
}
template <int NI> __device__ __forceinline__ void scan_sample_gd(const ScanArgs& a, int q, int lane) {
    const int grp16 = lane >> 4, l15 = lane & 15, ks = l15 * 8;
    f32x4 s0[NI], s1[NI], k0[NI][4], k1[NI][4], q0[NI][4], q1[NI][4]; float vv[NI][4], be[NI][4], gd[NI][4]; size_t so[NI]; int m0[NI], oc[NI];
#pragma unroll
    for (int ii = 0; ii < NI; ++ii) {
        const int j = NI * q + ii; const int bh = j >> 5, g = j & 31; const int b = bh >> 3, h = bh & 7; const int col = 4 * g + grp16;
        m0[ii] = NPR + 4 * b; oc[ii] = h * 128 + col; so[ii] = (size_t)bh * 16384 + (size_t)ks * 128 + col;
        const float* sp = a.st_gd + so[ii];
        s0[ii] = (f32x4){ldg1(sp), ldg1(sp + 128), ldg1(sp + 256), ldg1(sp + 384)}; s1[ii] = (f32x4){ldg1(sp + 512), ldg1(sp + 640), ldg1(sp + 768), ldg1(sp + 896)};
#pragma unroll
        for (int t = 0; t < 4; ++t) { const int m = m0[ii] + t; const size_t o = (size_t)m * 1024 + h * 128;
            k0[ii][t] = ldg4(a.KG + o + ks); k1[ii][t] = ldg4(a.KG + o + ks + 4); q0[ii][t] = ldg4(a.QG + o + ks); q1[ii][t] = ldg4(a.QG + o + ks + 4);
            vv[ii][t] = ldg1(a.VG + o + col); be[ii][t] = ldg1(a.BETA + (size_t)m * 1024 + h * 2); gd[ii][t] = ldg1(a.BETA + (size_t)m * 1024 + h * 2 + 1); }
    }
#pragma unroll
    for (int ii = 0; ii < NI; ++ii) {
        float osave = 0.f;
#pragma unroll
        for (int t = 0; t < 4; ++t) {
            const float d = reduce16(dot8(s0[ii], s1[ii], k0[ii][t], k1[ii][t]));
            const float gdec = gd[ii][t]; const float cc = be[ii][t] * (vv[ii][t] - gdec * d);
            s0[ii] = s0[ii] * gdec + k0[ii][t] * cc; s1[ii] = s1[ii] * gdec + k1[ii][t] * cc;
            const float o = reduce16(dot8(s0[ii], s1[ii], q0[ii][t], q1[ii][t]));
            osave = (l15 == t) ? o : osave;
        }
        if (l15 < 4) stg1(a.OGD + (size_t)(m0[ii] + l15) * 1024 + oc[ii], osave);
        float* sp = a.o_sgd + so[ii];
        stg1(sp, s0[ii].x); stg1(sp + 128, s0[ii].y); stg1(sp + 256, s0[ii].z); stg1(sp + 384, s0[ii].w);
        stg1(sp + 512, s1[ii].x); stg1(sp + 640, s1[ii].y); stg1(sp + 768, s1[ii].z); stg1(sp + 896, s1[ii].w);
    }
}

__device__ __forceinline__ void scan_prompt(const ScanArgs& a, LAS unsigned char* lds, int it, int tid, int wave, int lane, int hw, bool conv, const Args& args, unsigned char* convdst) {
    LAS float* buf = (LAS float*)lds;
    const bool rw = tid < 256; const int t2 = tid & 255;
    const int l15 = lane & 15, grp16 = lane >> 4;
    const int bh_r = it >> 2, part_r = it & 3, b_r = bh_r >> 4, h_r = bh_r & 15;
    const int bh_g = it >> 3, part_g = it & 7, b_g = bh_g >> 3, h_g = bh_g & 7;
    const int m0l = (rw ? b_r : b_g) * SEQ, hl = rw ? h_r : h_g, partl = rw ? part_r : part_g;
    unsigned e0 = sc_slot(rw, 0, t2, m0l, hl, partl); asm volatile("" : "+v"(e0));
    unsigned e1 = sc_slot(rw, 1, t2, m0l, hl, partl); asm volatile("" : "+v"(e1));
    unsigned e2 = sc_slot(rw, 2, t2, m0l, hl, partl); asm volatile("" : "+v"(e2));
    unsigned e3 = sc_slot(rw, 3, t2, m0l, hl, partl); asm volatile("" : "+v"(e3));
    unsigned e4 = sc_slot(rw, 4, t2, m0l, hl, partl); asm volatile("" : "+v"(e4));
    unsigned e5 = sc_slot(rw, 5, t2, m0l, hl, partl); asm volatile("" : "+v"(e5));
    constexpr int nch = SEQ / TC;
    f32x4 st0, st1, st2, st3, st4, st5;
#define SC_LOAD_ALL(c_) do { const int cc_ = (c_); st0 = sc_load(a.R, e0, cc_); st1 = sc_load(a.R, e1, cc_); st2 = sc_load(a.R, e2, cc_); st3 = sc_load(a.R, e3, cc_); st4 = sc_load(a.R, e4, cc_); st5 = sc_load(a.R, e5, cc_); } while (0)
#define SC_STORE_ALL(bf_) do { LAS float* b_ = (bf_); sc_store(b_, rw, 0, t2, st0); sc_store(b_, rw, 1, t2, st1); sc_store(b_, rw, 2, t2, st2); sc_store(b_, rw, 3, t2, st3); sc_store(b_, rw, 4, t2, st4); sc_store(b_, rw, 5, t2, st5); } while (0)
    f32x4 sa0 = {0.f, 0.f, 0.f, 0.f}, sa1 = sa0, sb0 = sa0, sb1 = sa0;
    const int cw = wave & 1;
    const int rl = cw * 8 + grp16 * 2;
    const int rc = (wave < 2 ? part_g : part_r) * 16 + rl;
    SC_LOAD_ALL(0); SC_STORE_ALL(buf); __syncthreads();
    if (wave < 4) __builtin_amdgcn_s_setprio(3);
    for (int c = 0; c < nch; ++c) {
        LAS float* cur = buf + (c & 1) * SC_BUF;
        if (c + 1 < nch) SC_LOAD_ALL(c + 1);
        float* op = nullptr; f32x2 ov = {0.f, 0.f};
        if (wave >= 4) {
            int lane2 = lane; asm volatile("" : "+v"(lane2));
            if (c & 1) { const int u = hw + 1024 * (c >> 1); if (u < 32768) scan_sample_rw<1>(a, u, lane2); else scan_sample_gd<1>(a, u - 32768, lane2); }
            if (conv && (c % 9) == 3) { const int ci = hw + 1024 * (c / 9);
#define INL(i) ({ int _i = (i); asm volatile("" : "+s"(_i)); args.in[_i]; })
                const LayerW L1{INL(9) + (size_t)DM * INC, INL(25) + (size_t)DM * DM, INL(28) + (size_t)DM * XAW, INL(29) + (size_t)DM * XAW, INL(30) + (size_t)DM * XAW,
                                INL(31) + (size_t)XAW * DM, INL(34) + (size_t)DM * FF, INL(35) + (size_t)DM * FF, INL(36) + (size_t)FF * DM, INL(12) + 65536, INL(14) + 65536, INL(15) + 131072};
                if (ci < CONV_NIT) convert_item(L1, convdst, (float*)((unsigned char*)lds + 2 * SC_BUF * 4) + (wave - 4) * 4160, ci, lane2); }
        } else if (wave == 2 || wave == 3) {
            const LAS float* bs = cur + l15 * 4; const LAS float* bv = cur + 320 + rl;
            float osa = 0.f, osb = 0.f;
            f32x4 w4 = *(const LAS f32x4*)bs, a4 = *(const LAS f32x4*)(bs + 64), b4 = *(const LAS f32x4*)(bs + 128), k4 = *(const LAS f32x4*)(bs + 192), r4 = *(const LAS f32x4*)(bs + 256);
            f32x2 vv = *(const LAS f32x2*)bv;
#pragma unroll
            for (int stp = 0; stp < TC; ++stp) {
                f32x4 nw = w4, na = a4, nb = b4, nk = k4, nr = r4; f32x2 nv = vv;
                if (stp + 1 < TC) { const LAS float* p = bs + (stp + 1) * RW_STEP;
                    nw = *(const LAS f32x4*)p; na = *(const LAS f32x4*)(p + 64); nb = *(const LAS f32x4*)(p + 128); nk = *(const LAS f32x4*)(p + 192); nr = *(const LAS f32x4*)(p + 256); nv = *(const LAS f32x2*)(bv + (stp + 1) * RW_STEP); }
                const float da = reduce16(dot4(sa0, a4)), db = reduce16(dot4(sb0, a4));
                sa0 = sa0 * w4 + (b4 * da + k4 * vv.x); sb0 = sb0 * w4 + (b4 * db + k4 * vv.y);
                const float oa = reduce16(dot4(sa0, r4)), ob = reduce16(dot4(sb0, r4));
                osa = (l15 == stp) ? oa : osa; osb = (l15 == stp) ? ob : osb;
                w4 = nw; a4 = na; b4 = nb; k4 = nk; r4 = nr; vv = nv;
            }
            op = a.ORW + (size_t)(b_r * SEQ + c * TC + l15) * 1024 + h_r * 64 + rc; ov = (f32x2){osa, osb};
        } else if (wave < 2) {
            const LAS float* bs = cur + TC * RW_STEP + l15 * 8; const LAS float* bv = cur + TC * RW_STEP + 256 + rl; const LAS float* bg = cur + TC * RW_STEP + 272;
            float osa = 0.f, osb = 0.f;
            f32x4 k0 = *(const LAS f32x4*)bs, k1 = *(const LAS f32x4*)(bs + 4), q0 = *(const LAS f32x4*)(bs + 128), q1 = *(const LAS f32x4*)(bs + 132);
            f32x2 vv = *(const LAS f32x2*)bv; f32x2 bg2 = *(const LAS f32x2*)bg;
#pragma unroll
            for (int stp = 0; stp < TC; ++stp) {
                f32x4 nk0 = k0, nk1 = k1, nq0 = q0, nq1 = q1; f32x2 nv = vv; f32x2 nbg = bg2;
                if (stp + 1 < TC) { const LAS float* p = bs + (stp + 1) * GD_STEP;
                    nk0 = *(const LAS f32x4*)p; nk1 = *(const LAS f32x4*)(p + 4); nq0 = *(const LAS f32x4*)(p + 128); nq1 = *(const LAS f32x4*)(p + 132); nv = *(const LAS f32x2*)(bv + (stp + 1) * GD_STEP); nbg = *(const LAS f32x2*)(bg + (stp + 1) * GD_STEP); }
                const float da = reduce16(dot8(sa0, sa1, k0, k1)), db = reduce16(dot8(sb0, sb1, k0, k1));
                const float gdec = bg2.y; const float ca = bg2.x * (vv.x - gdec * da), cb = bg2.x * (vv.y - gdec * db);
                sa0 = sa0 * gdec + k0 * ca; sa1 = sa1 * gdec + k1 * ca; sb0 = sb0 * gdec + k0 * cb; sb1 = sb1 * gdec + k1 * cb;
                const float oa = reduce16(dot8(sa0, sa1, q0, q1)), ob = reduce16(dot8(sb0, sb1, q0, q1));
                osa = (l15 == stp) ? oa : osa; osb = (l15 == stp) ? ob : osb;
                k0 = nk0; k1 = nk1; q0 = nq0; q1 = nq1; vv = nv; bg2 = nbg;
            }
            op = a.OGD + (size_t)(b_g * SEQ + c * TC + l15) * 1024 + h_g * 128 + rc; ov = (f32x2){osa, osb};
        }
        if (c + 1 < nch) SC_STORE_ALL(buf + ((c + 1) & 1) * SC_BUF);
        if (wave < 4) *(GAS f32x2*)op = ov;
        asm volatile("s_waitcnt lgkmcnt(0)" ::: "memory"); __builtin_amdgcn_s_barrier(); asm volatile("" ::: "memory");
    }
    __builtin_amdgcn_s_setprio(0);
    if (wave == 2 || wave == 3) { float* sp = a.o_prw + (size_t)bh_r * 4096 + rc * 64 + l15 * 4; stg4(sp, sa0); stg4(sp + 64, sb0); }
    else if (wave < 2) { float* sp = a.o_pgd + (size_t)bh_g * 16384 + (size_t)(l15 * 8) * 128 + rc;
#pragma unroll
        for (int e = 0; e < 4; ++e) { *(GAS f32x2*)(sp + (size_t)e * 128) = (f32x2){sa0[e], sb0[e]}; *(GAS f32x2*)(sp + (size_t)(4 + e) * 128) = (f32x2){sa1[e], sb1[e]}; } }
}

struct PostArgs {
    const bf16* P; const float *R, *K, *V, *G, *ORW, *OGD; const float *rk, *lnxw, *lnxb, *normw; bf16* MIX;
};
__device__ __forceinline__ void post_row(const PostArgs& a, int m, int lane) {
    const size_t rb = (size_t)m * 1024;
    f32x4 o[4], r[4], k[4], v[4], g[4];
#pragma unroll
    for (int j = 0; j < 4; ++j) { const int col = j * 256 + 4 * lane;
        o[j] = ldg4(a.ORW + rb + col); r[j] = ldg4(a.R + rb + col); k[j] = ldg4(a.K + rb + col); v[j] = ldg4(a.V + rb + col); g[j] = ldg4(a.G + rb + col); }
#pragma unroll
    for (int j = 0; j < 4; ++j) { const int col = j * 256 + 4 * lane;
        const f32x4 lw = ldg4(a.lnxw + col), lb = ldg4(a.lnxb + col), rk = ldg4(a.rk + col);
        const float mu = reduce16((o[j].x + o[j].y) + (o[j].z + o[j].w)) * (1.f / 64.f); const f32x4 d = o[j] - mu;
        const float var = reduce16(dot4(d, d)) * (1.f / 64.f); const float rs = rsqf_(var + 64e-5f);
        const float bs = reduce16(dot4(r[j] * k[j], rk));
        const f32x4 y = (d * rs * lw + lb + v[j] * bs) * g[j];
        u32x2 w; w.x = pk2(y.x, y.y); w.y = pk2(y.z, y.w);
        *(GAS u32x2*)(a.MIX + (size_t)m * DM + col) = w; }
    f32x4 og[4], z[4];
#pragma unroll
    for (int j = 0; j < 4; ++j) { const int col = j * 256 + 4 * lane; og[j] = ldg4(a.OGD + rb + col); z[j] = ldb4(a.P + (size_t)m * PLD + GD0 + 3072 + col); }
    const f32x4 nw = ldg4(a.normw + 4 * (lane & 31));
#pragma unroll
    for (int j = 0; j < 4; ++j) { const int col = j * 256 + 4 * lane;
        float ms = reduce16(dot4(og[j], og[j])); ms += __shfl_xor(ms, 16); const float rs = rsqf_(ms * (1.f / 128.f) + 1e-6f);
        f32x4 y;
#pragma unroll
        for (int e = 0; e < 4; ++e) y[e] = og[j][e] * rs * nw[e] * (z[j][e] * sigmoidf_(z[j][e]));
        u32x2 w; w.x = pk2(y.x, y.y); w.y = pk2(y.z, y.w);
        *(GAS u32x2*)(a.MIX + (size_t)m * DM + 1024 + col) = w; }
}

constexpr int KP = 136, VP = 132;
__device__ __forceinline__ void attn_unit(const float* Kp, const float* Vp, const float* Q, bf16* AO, int mrow0, int nvalid, bool all_waves, int hcol,
                                          unsigned char* lds, int tid, int wave, int lane) {
    bf16* Ks = (bf16*)lds; bf16* Vs = Ks + 256 * KP;
#pragma unroll
    for (int i0 = 0; i0 < 16; i0 += 8) {
        f32x4 kk8[8], vv8[8];
#pragma unroll
        for (int j = 0; j < 8; ++j) { const int idx = tid + NTHR * (i0 + j); const int key = idx >> 5, d4 = (idx & 31) * 4;
            kk8[j] = ldg4(Kp + (size_t)key * 512 + d4); vv8[j] = ldg4(Vp + (size_t)key * 512 + d4); }
#pragma unroll
        for (int j = 0; j < 8; ++j) { const int idx = tid + NTHR * (i0 + j); const int key = idx >> 5, d4 = (idx & 31) * 4;
            const f32x4 kv = kk8[j], vv = vv8[j];
            u32x2 a, b; a.x = pk2(kv.x, kv.y); a.y = pk2(kv.z, kv.w); b.x = pk2(vv.x, vv.y); b.y = pk2(vv.z, vv.w);
            *(u32x2*)(Ks + key * KP + d4) = a; *(u32x2*)(Vs + key * VP + d4) = b; }
    }
    __syncthreads();
    if (all_waves || wave == 0) {
        const int quad = lane >> 4, l15 = lane & 15;
        const int qr = (all_waves ? wave * 16 : 0) + l15; const bool valid = qr < nvalid; const int m = mrow0 + qr;
        bf16x8 qf[4];
#pragma unroll
        for (int ds = 0; ds < 4; ++ds) {
            f32x4 x0 = {0.f, 0.f, 0.f, 0.f}, x1 = x0;
            if (valid) { const float* qp = Q + (size_t)m * XAW + hcol + 32 * ds + quad * 8; x0 = ldg4(qp); x1 = ldg4(qp + 4); }
            u32x4 w; w.x = pk2(x0.x, x0.y); w.y = pk2(x0.z, x0.w); w.z = pk2(x1.x, x1.y); w.w = pk2(x1.z, x1.w);
            qf[ds] = __builtin_bit_cast(bf16x8, w);
        }
        f32x4 sc[16];
#pragma unroll
        for (int kt = 0; kt < 16; ++kt) {
            sc[kt] = (f32x4){0.f, 0.f, 0.f, 0.f};
#pragma unroll
            for (int ds = 0; ds < 4; ++ds) {
                const bf16x8 kf = *(const bf16x8*)(Ks + (16 * kt + l15) * KP + 32 * ds + quad * 8);
                sc[kt] = __builtin_amdgcn_mfma_f32_16x16x32_bf16(kf, qf[ds], sc[kt], 0, 0, 0);
            }
        }
        float mx = -3.0e38f;
#pragma unroll
        for (int kt = 0; kt < 16; ++kt) mx = fmaxf(mx, fmaxf(fmaxf(sc[kt].x, sc[kt].y), fmaxf(sc[kt].z, sc[kt].w)));
        mx = fmaxf(mx, __shfl_xor(mx, 16)); mx = fmaxf(mx, __shfl_xor(mx, 32));
        const float c2 = 0.08838834764831845f * 1.4426950408889634f; float sum = 0.f;
        bf16x8 pb[8];
#pragma unroll
        for (int ks = 0; ks < 8; ++ks) {
            float p[8];
#pragma unroll
            for (int e = 0; e < 4; ++e) { p[e] = exp2f((sc[2 * ks][e] - mx) * c2); p[4 + e] = exp2f((sc[2 * ks + 1][e] - mx) * c2); }
            sum += ((p[0] + p[1]) + (p[2] + p[3])) + ((p[4] + p[5]) + (p[6] + p[7]));
            u32x4 w; w.x = pk2(p[0], p[1]); w.y = pk2(p[2], p[3]); w.z = pk2(p[4], p[5]); w.w = pk2(p[6], p[7]);
            pb[ks] = __builtin_bit_cast(bf16x8, w);
        }
        sum += __shfl_xor(sum, 16); sum += __shfl_xor(sum, 32);
        const float inv = rcpf_(sum);
#pragma unroll
        for (int nt = 0; nt < 8; ++nt) {
            f32x4 o = {0.f, 0.f, 0.f, 0.f};
            const bf16* vcol = Vs + 16 * nt + l15;
#pragma unroll
            for (int ks = 0; ks < 8; ++ks) {
                const bf16* v0 = vcol + (32 * ks + 4 * quad) * VP; const bf16* v1 = v0 + 16 * VP;
                u32x4 w;
                w.x = (unsigned)v0[0] | ((unsigned)v0[VP] << 16); w.y = (unsigned)v0[2 * VP] | ((unsigned)v0[3 * VP] << 16);
                w.z = (unsigned)v1[0] | ((unsigned)v1[VP] << 16); w.w = (unsigned)v1[2 * VP] | ((unsigned)v1[3 * VP] << 16);
                o = __builtin_amdgcn_mfma_f32_16x16x32_bf16(__builtin_bit_cast(bf16x8, w), pb[ks], o, 0, 0, 0);
            }
            if (valid) { u32x2 w; w.x = pk2(o.x * inv, o.y * inv); w.y = pk2(o.z * inv, o.w * inv); *(GAS u32x2*)(AO + (size_t)m * XAW + hcol + 16 * nt + quad * 4) = w; }
        }
    }
    __syncthreads();
}

#define RLX_AGENT __ATOMIC_RELAXED, __HIP_MEMORY_SCOPE_AGENT
#define XB_TMO      128
#define XB_XCNT(j)  (256  + 64 * (j))
#define XB_XSUB(j)  (1280 + 64 * (j))
#define XB_XGEN(j)  (2304 + 64 * (j))
#define XB_TOP      3328
#define XB_TOPGEN   3392
#define XCD_BAR_WORDS 3456
#define XB_SPIN_CAP (1u << 18)

__device__ __forceinline__ unsigned xb_ld(unsigned* p)              { return __hip_atomic_load(p, __ATOMIC_RELAXED, __HIP_MEMORY_SCOPE_AGENT); }
__device__ __forceinline__ unsigned xb_add(unsigned* p, unsigned v) { return __hip_atomic_fetch_add(p, v, __ATOMIC_RELAXED, __HIP_MEMORY_SCOPE_AGENT); }
__device__ __forceinline__ unsigned xb_xcc_id() { return (unsigned)__builtin_amdgcn_s_getreg((3 << 11) | 20) & 0xFu; }
#define XB_SPIN(cond, bar) do { unsigned _sp = 0; while (cond) { __builtin_amdgcn_s_sleep(1); \
    if ((++_sp & 255u) == 0u) { if (xb_ld(&(bar)[XB_TMO])) break; if (_sp > XB_SPIN_CAP) { atomicAdd(&(bar)[XB_TMO], 1u); break; } } } } while (0)

struct XcdBarrier {
    unsigned* bar; unsigned x;
    volatile LAS unsigned* st;
};

__device__ __forceinline__ XcdBarrier xcd_barrier_post(unsigned* bar, volatile LAS unsigned* st) {
    XcdBarrier b; b.bar = bar; b.x = xb_xcc_id(); b.st = st;
    if (threadIdx.x == 0) (void)xb_add(&bar[XB_XCNT(b.x)], 1u);
    return b;
}
__device__ __forceinline__ void xcd_barrier_complete(unsigned* bar, unsigned x, unsigned& nloc, unsigned& nx) {
    const unsigned G = gridDim.x * gridDim.y * gridDim.z;
    unsigned sum, cnt, mine, sp = 0u;
    for (;;) {
        sum = 0u; cnt = 0u; mine = 0u;
#pragma unroll
        for (unsigned j = 0; j < 16; ++j) { const unsigned c = xb_ld(&bar[XB_XCNT(j)]); sum += c; cnt += (c > 0u) ? 1u : 0u; mine = (j == x) ? c : mine; }
        if (sum == G) break;
        __builtin_amdgcn_s_sleep(1);
        if ((++sp & 255u) == 0u) { if (xb_ld(&bar[XB_TMO])) break; if (sp > XB_SPIN_CAP) { atomicAdd(&bar[XB_TMO], 1u); break; } }
    }
    nloc = mine > 0u ? mine : 1u; nx = cnt > 0u ? cnt : 1u;
}

__device__ __forceinline__ void xcd_barrier(const XcdBarrier& b) {
    asm volatile("s_waitcnt vmcnt(0)" ::: "memory");
    __syncthreads();
    if (threadIdx.x == 0) {
        unsigned* bar = b.bar;
        __builtin_amdgcn_s_waitcnt(0);
        unsigned nloc = b.st[0], nx = b.st[1];
        if (nloc == 0u) { xcd_barrier_complete(bar, b.x, nloc, nx); b.st[0] = nloc; b.st[1] = nx; }
        const unsigned old = xb_add(&bar[XB_XSUB(b.x)], 1u);
        const unsigned gen = old / nloc;
        if (old + 1u == (gen + 1u) * nloc) {
            __builtin_amdgcn_fence(__ATOMIC_RELEASE, "agent");
            asm volatile("s_waitcnt vmcnt(0)" ::: "memory");
            const unsigned og = xb_add(&bar[XB_TOP], 1u);
            const unsigned tg = og / nx;
            if (og + 1u == (tg + 1u) * nx) xb_add(&bar[XB_TOPGEN], 1u);
            else XB_SPIN(xb_ld(&bar[XB_TOPGEN]) == tg, bar);
            __builtin_amdgcn_fence(__ATOMIC_ACQUIRE, "agent");
            xb_add(&bar[XB_XGEN(b.x)], 1u);
            asm volatile("s_waitcnt vmcnt(0)" ::: "memory");
        } else {
            XB_SPIN(xb_ld(&bar[XB_XGEN(b.x)]) == gen, bar);
            __builtin_amdgcn_fence(__ATOMIC_ACQUIRE, "agent");
            asm volatile("s_waitcnt vmcnt(0)" ::: "memory");
        }
    }
    __syncthreads();
}

constexpr int NPHASE = 27;

#ifndef DUP_MASK
#define DUP_MASK 0
#endif
#ifndef SAMPLE_REPS
#define SAMPLE_REPS 1
#endif
__global__ void __launch_bounds__(NTHR, 2) fwd_megakernel(Args args) {
    extern __shared__ __attribute__((aligned(16))) unsigned char lds[];
    cg::grid_group grid = cg::this_grid();
    const int G = gridDim.x, bx = blockIdx.x;
    const int lo = args.ph_lo, hi = args.ph_hi;
#define IN(i) ({ int _i = (i); asm volatile("" : "+s"(_i)); args.in[_i]; })

    unsigned* barw = (unsigned*)(args.ws + 16384);
    volatile LAS unsigned* MISC = (volatile LAS unsigned*)((LAS unsigned char*)lds + (LDS_BYTES - 64));
    if (threadIdx.x < 16) MISC[threadIdx.x] = 0u;
    if (bx == 0) { for (int i = threadIdx.x; i < XCD_BAR_WORDS; i += NTHR) __hip_atomic_store(barw + i, 0u, RLX_AGENT); }
    __syncthreads();
    unsigned xid = 0; bool xposted = false;

    for (int ph = lo; ph < hi; ++ph) {
        if (ph > lo) {
            unsigned* bw = (unsigned*)(args.ws + 16384); asm volatile("" : "+s"(bw));
            if (!xposted) { grid.sync(); const XcdBarrier t = xcd_barrier_post(bw, MISC + 8); xid = t.x; xposted = true; }
            else { XcdBarrier t; t.bar = bw; t.x = xid; t.st = MISC + 8; xcd_barrier(t); }
        }
        const int nrep = ((DUP_MASK >> (ph == 0 ? 0 : ((ph - 1) % 13) + 1)) & 1) ? 2 : 1;
        for (int rep = 0; rep < nrep; ++rep) {
        int tid = threadIdx.x; asm volatile("" : "+v"(tid));
        const int lane = tid & 63, wave = __builtin_amdgcn_readfirstlane(tid >> 6);
        const int gw = bx * NWAVES + wave, NGW = G * NWAVES;
        unsigned char* ws = args.ws; asm volatile("" : "+s"(ws));
        float* out = args.out; asm volatile("" : "+s"(out));
        PG8_LAS unsigned char* ldsl = (PG8_LAS unsigned char*)lds;
        float* X = (float*)(ws + WS_X); bf16* Xb = (bf16*)(ws + WS_XB); float* PRE = (float*)(ws + WS_PRE); bf16* P = (bf16*)(ws + WS_P);
        const int l = ph == 0 ? 0 : (ph - 1) / 13; const int k = ph == 0 ? -1 : (ph - 1) % 13;
        unsigned char* wb = ws + (l ? W1OFF : 0);
        if (ph == 0) {
            LayerW L{IN(9), IN(25), IN(28), IN(29), IN(30), IN(31), IN(34), IN(35), IN(36), IN(12), IN(14), IN(15)};
            if (G == 256) { for (int i2 = gw; i2 < CONV_NIT - 2816; i2 += NGW) convert_item(L, ws, (float*)lds + wave * 4160, i2 < 9376 ? i2 : i2 + 2816, lane); }
            else convert_weights(L, ws, (float*)lds + wave * 4160, gw, NGW, lane);
            for (int m = gw; m < MROWS; m += NGW) row_copy_cvt(m < NPR ? IN(0) + (size_t)m * DM : IN(2) + (size_t)(m - NPR) * DM, nullptr, Xb + (size_t)m * DM, lane);
            for (int m = gw; m < 1024; m += NGW) row_copy_cvt(IN(1) + (size_t)m * DM, nullptr, (bf16*)(ws + WS_MEMB) + (size_t)m * DM, lane);
            continue;
        }
        if (k == 6 && l == 0 && G == 256 && (bx >= 68 && (bx < 128 || bx >= 144))) {
            const int idx = bx < 128 ? bx - 68 : bx - 144 + 60;
            LayerW L{IN(9), IN(25), IN(28), IN(29), IN(30), IN(31), IN(34), IN(35), IN(36), IN(12), IN(14), IN(15)};
            for (int i2 = idx * NWAVES + wave; i2 < 2816; i2 += 172 * NWAVES) convert_item(L, ws, (float*)lds + wave * 4160, 9376 + i2, lane);
            continue;
        }
        if (k == 0 || k == 4 || k == 6 || k == 8 || k == 10 || k == 11) {
            const int nsub = (k == 0 || k == 10) ? 1 : 2;
            for (int sub = 0; sub < nsub; ++sub) {
                pg8::Gemm g; pg8::EpiGen E; int cshift = 0;
                E.mode = 0; E.O = PRE; E.ldc = DM; E.res = X; E.alpha = ALPHA; E.split_cols = 0; E.split_stride = 0; E.H = (bf16*)(ws + WS_H); E.ldh = FF; E.nkt = 0; E.kplane = 0;
                g.A = Xb; g.M = MROWS; g.N = DM; g.K = DM; g.Bt = (const bf16*)(wb + WS_WOUT);
                if (k == 0) { g.Bt = (const bf16*)(wb + WS_WIN); g.N = PLD; E.mode = 3; E.H = P; E.ldh = PLD; E.res = nullptr; }
                else if (k == 4) { g.A = (const bf16*)(ws + WS_MIX); if (l == 0) E.res = IN(0); }
                else if (k == 6 && sub == 0) { g.Bt = (const bf16*)(wb + WS_WQ); g.N = XAW; E.O = (float*)(ws + WS_Q); E.ldc = XAW; E.res = nullptr; }
                else if (k == 6) { g.A = (const bf16*)(ws + WS_MEMB); g.Bt = (const bf16*)(wb + WS_WKV); g.M = 1024; g.N = 1024; cshift = 128;
                    E.O = out + O_PMK + (size_t)l * 4 * 256 * 512; E.ldc = 512; E.res = nullptr; E.split_cols = 512; E.split_stride = (size_t)(O_PMV - O_PMK); }
                else if (k == 8) { g.A = (const bf16*)(ws + WS_AO); g.Bt = (const bf16*)(wb + WS_WO); g.K = XAW; }
                else if (k == 10) { g.Bt = (const bf16*)(wb + WS_WGU); g.N = 2 * FF; E.mode = 1; }
                else { g.A = (const bf16*)(ws + WS_H); g.Bt = (const bf16*)(wb + WS_WD); g.K = FF; }
                int nsplit = 1;
                if ((k == 4 || k == 8 || k == 11) && sub == 0) { g.M = NPR; E.mode = 4; E.H = (bf16*)PRE; E.ldh = DM; }
                if ((k == 4 || k == 8 || k == 11) && sub == 1) {
                    g.A += (size_t)NPR * g.K; g.M = NSM; nsplit = (k == 4) ? 8 : (k == 8) ? 4 : 11;
                    E.O = (float*)(ws + WS_PART); E.res = (k == 4 && l == 0) ? IN(2) : X + (size_t)NPR * DM; E.nkt = g.K / 64 / nsplit; E.kplane = (size_t)NSM * DM; }
                g.nt = g.K / 64 / nsplit;
                pg8::StaticOrder S; S.init(g.M, g.N, G, (bx + cshift) % G); S.nsplit = nsplit; S.nkt = g.nt;
                pg8::gemm_phase<pg8::EpiGen, pg8::StaticOrder, true, true>(ldsl, g, S, E);
                __syncthreads();
            }
            continue;
        }
        switch (k) {
        case 1: {
            PrepArgs a;
            a.P = P; a.state_shift = IN(4) + (size_t)l * 128 * RWC; a.state_conv = IN(6) + (size_t)l * 128 * 3 * 3072;
            a.mu = IN(10) + l * RWC; a.w0 = IN(11) + l * 1024; a.a0 = IN(13) + l * 1024; a.kkw = IN(16) + l * 1024; a.kaw = IN(17) + l * 1024;
            a.convw = IN(21) + l * 4 * 3072; a.alog = IN(22) + l * 8; a.dtb = IN(23) + l * 8;
            a.W2t = (const bf16*)(wb + WS_LORA); a.A2t = a.W2t + 65536; a.G2t = a.W2t + 131072;
            a.R = (float*)(ws + WS_R); a.W = (float*)(ws + WS_W); a.K = (float*)(ws + WS_K); a.V = (float*)(ws + WS_V); a.A = (float*)(ws + WS_A); a.B = (float*)(ws + WS_B); a.G = (float*)(ws + WS_G);
            a.QG = (float*)(ws + WS_QG); a.KG = (float*)(ws + WS_KG); a.VG = (float*)(ws + WS_VG); a.BETA = (float*)(ws + WS_BG); a.GDEC = a.BETA + MROWS * 8;
            a.o_psh = out + O_PSH + (size_t)l * 4 * RWC; a.o_pcv = out + O_PCV + (size_t)l * 4 * 3 * 3072; a.o_ssh = out + O_SSH + (size_t)l * 128 * RWC; a.o_scv = out + O_SCV + (size_t)l * 128 * 3 * 3072;
            const int vcu1 = (G % 8 == 0) ? (bx % 8) * (G / 8) + bx / 8 : bx;
            for (int u = vcu1; u < (MROWS / 32) * 4; u += G) prep_rw_unit(a, ldsl, u, tid, wave, lane);
            for (int q = gw; q < MROWS * 4; q += NGW) prep_gd_pair(a, q, lane);
            for (int u = gw; u < 528; u += NGW) prep_copy_unit(a, u, lane);
        } break;
        case 2: {
            ScanArgs a;
            a.R = (const float*)(ws + WS_R); a.W = (const float*)(ws + WS_W); a.K = (const float*)(ws + WS_K); a.V = (const float*)(ws + WS_V); a.A = (const float*)(ws + WS_A); a.B = (const float*)(ws + WS_B);
            a.QG = (const float*)(ws + WS_QG); a.KG = (const float*)(ws + WS_KG); a.VG = (const float*)(ws + WS_VG); a.BETA = (const float*)(ws + WS_BG); a.GDEC = a.BETA + MROWS * 8;
            a.st_rw = IN(3) + (size_t)l * 128 * 16 * 4096; a.st_gd = IN(5) + (size_t)l * 128 * 8 * 16384;
            a.ORW = (float*)(ws + WS_ORW); a.OGD = (float*)(ws + WS_OGD);
            a.o_prw = out + O_PRW + (size_t)l * 4 * 16 * 4096; a.o_pgd = out + O_PGD + (size_t)l * 4 * 8 * 16384;
            a.o_srw = out + O_SRW + (size_t)l * 128 * 16 * 4096; a.o_sgd = out + O_SGD + (size_t)l * 128 * 8 * 16384;
            const int vcu = (G % 8 == 0) ? (bx % 8) * (G / 8) + bx / 8 : bx;
            if (G == 256) {
                scan_prompt(a, ldsl, vcu, tid, wave, lane, vcu * 4 + (wave & 3), l == 0, args, ws + W1OFF);
            } else {
                for (int it = vcu; it < 256; it += G) scan_prompt(a, ldsl, it, tid, wave, lane, 0, false, args, nullptr);
                for (int srep = 0; srep < SAMPLE_REPS; ++srep)
                for (int u = vcu * NWAVES + wave; u < 32768; u += NGW) { if (u < 16384) scan_sample_rw<2>(a, u, lane); else scan_sample_gd<2>(a, u - 16384, lane); }
            }
        } break;
        case 3: {
            PostArgs a;
            a.P = P; a.R = (const float*)(ws + WS_R); a.K = (const float*)(ws + WS_K); a.V = (const float*)(ws + WS_V); a.G = (const float*)(ws + WS_G);
            a.ORW = (const float*)(ws + WS_ORW); a.OGD = (const float*)(ws + WS_OGD);
            a.rk = IN(18) + l * 1024; a.lnxw = IN(19) + l * 1024; a.lnxb = IN(20) + l * 1024; a.normw = IN(24) + l * 128; a.MIX = (bf16*)(ws + WS_MIX);
            for (int m = gw; m < MROWS; m += NGW) post_row(a, m, lane);
        } break;
        case 5: case 9: case 12: {
            const int gi = k == 5 ? 26 : k == 9 ? 32 : 37;
            const float* gg = IN(gi) + l * DM; const float* bb = IN(gi + 1) + l * DM;
            const bool fin = (k == 12 && l == 1);
            for (int m = gw; m < MROWS; m += NGW) {
                float* df = fin ? (m < NPR ? out + O_YP + (size_t)m * DM : out + O_YS + (size_t)(m - NPR) * DM) : X + (size_t)m * DM;
                const bool smp = m >= NPR;
                ln_row((const float*)(ws + WS_PART) + (size_t)(smp ? m - NPR : 0) * DM, smp ? nullptr : (const bf16*)PRE + (size_t)m * DM, smp ? (k == 5 ? 8 : k == 9 ? 4 : 11) : 1, gg, bb, df, fin ? nullptr : Xb + (size_t)m * DM, lane);
            }
            if (k == 12 && l == 0 && G != 256) {
                LayerW L{IN(9) + (size_t)DM * INC, IN(25) + (size_t)DM * DM, IN(28) + (size_t)DM * XAW, IN(29) + (size_t)DM * XAW, IN(30) + (size_t)DM * XAW,
                         IN(31) + (size_t)XAW * DM, IN(34) + (size_t)DM * FF, IN(35) + (size_t)DM * FF, IN(36) + (size_t)FF * DM,
                         IN(12) + 65536, IN(14) + 65536, IN(15) + 131072};
                convert_weights(L, ws + W1OFF, (float*)lds + wave * 4160, gw, NGW, lane);
            }
        } break;
        case 7: {
            const float* Q = (const float*)(ws + WS_Q); bf16* AO = (bf16*)(ws + WS_AO);
            const int vcu7 = (G % 8 == 0) ? (bx % 8) * (G / 8) + bx / 8 : bx;
            for (int u = vcu7; u < 256 + 512; u += G) {
                if (u < 256) { const int b = u >> 6, h = (u >> 4) & 3, qb = u & 15;
                    const size_t kvo = ((size_t)(l * 4 + b) * 256) * 512 + h * 128;
                    attn_unit(out + O_PMK + kvo, out + O_PMV + kvo, Q, AO, b * SEQ + qb * 128, 128, true, h * 128, lds, tid, wave, lane);
                } else { const int j = u - 256; const int b = j >> 2, h = j & 3;
                    const size_t kvo = ((size_t)(l * 128 + b) * 256) * 512 + h * 128;
                    attn_unit(IN(7) + kvo, IN(8) + kvo, Q, AO, NPR + b * 4, 4, false, h * 128, lds, tid, wave, lane);
                }
            }
        } break;
        default: break;
        }
        }
    }
}

#ifndef MK_PER_PHASE
#define MK_PER_PHASE 0
#endif
extern "C" void kernel_launch(void* const* d_in, const int* in_sizes, int n_in, void* d_out, int out_size, void* d_ws, size_t ws_size, hipStream_t stream) {
    static int grid = 0;
    if (grid == 0) {
        if (n_in != 39 || (size_t)out_size != O_END || ws_size < WS_END) { fprintf(stderr, "kernel_launch: unexpected sizes n_in %d out %d ws %zu (need %zu)\n", n_in, out_size, ws_size, (size_t)WS_END); }
        int dev = 0, cus = 0, per_cu = 0;
        hipGetDevice(&dev); hipDeviceGetAttribute(&cus, hipDeviceAttributeMultiprocessorCount, dev);
        hipFuncSetAttribute((const void*)fwd_megakernel, hipFuncAttributeMaxDynamicSharedMemorySize, LDS_BYTES);
        hipOccupancyMaxActiveBlocksPerMultiprocessor(&per_cu, (const void*)fwd_megakernel, NTHR, LDS_BYTES);
        if (per_cu < 1) { fprintf(stderr, "kernel_launch: occupancy query says %d\n", per_cu); per_cu = 1; }
        grid = cus * 1;
        if (cus <= 0) grid = 256;
    }
    Args a{};
    for (int i = 0; i < 39; ++i) a.in[i] = (const float*)d_in[i];
    a.out = (float*)d_out; a.ws = (unsigned char*)d_ws;
#if MK_PER_PHASE
    for (int p = 0; p < NPHASE; ++p) { a.ph_lo = p; a.ph_hi = p + 1; void* kargs[] = {&a};
        hipError_t e = hipLaunchCooperativeKernel((const void*)fwd_megakernel, dim3(grid), dim3(NTHR), kargs, LDS_BYTES, stream);
        if (e != hipSuccess) { fprintf(stderr, "launch %d failed: %s\n", p, hipGetErrorString(e)); break; } }
#else
    a.ph_lo = 0; a.ph_hi = NPHASE; void* kargs[] = {&a};
    hipError_t e = hipLaunchCooperativeKernel((const void*)fwd_megakernel, dim3(grid), dim3(NTHR), kargs, LDS_BYTES, stream);
    if (e != hipSuccess) fprintf(stderr, "cooperative launch failed: %s (grid %d)\n", hipGetErrorString(e), grid);
#endif
}
```

```cpp
#include <hip/hip_runtime.h>
#include <hip/hip_cooperative_groups.h>
#include <cstdio>
#include <cstdint>
namespace cg = cooperative_groups;
#define DUP_MASK 0
#define SAMPLE_REPS 1
namespace pg8 {
#define PG8_LAS __attribute__((address_space(3)))
typedef unsigned short bf16_t;
typedef short bf16x8 __attribute__((ext_vector_type(8)));
typedef float f32x4 __attribute__((ext_vector_type(4)));
typedef unsigned u32x4 __attribute__((ext_vector_type(4)));
constexpr int BM = 256, BK = 64, HALF = 128, HTB = HALF * BK * 2  , STAGE_BYTES = 8 * HTB, NXCD = 8, WGM = 8;

__host__ __device__ __forceinline__ int lds_byte(int r, int c) { const int st = (r >> 4) * 2 + (c >> 5), rr = r & 15, cc = c & 31, ob = rr * 64 + cc * 2; return st * 1024 + (ob ^ (((ob >> 9) & 1) << 5)); }
__host__ __device__ __forceinline__ void stage_rc(int b, int& R, int& C) { const int st = b / 1024, sb = b % 1024, swz = sb ^ (((sb >> 9) & 1) << 5); R = (st >> 1) * 16 + swz / 64; C = (st & 1) * 32 + (swz % 64) / 2; }
__host__ __device__ __forceinline__ int perm32(int rho) { const int n = rho >> 4, i = rho & 15; return 8 * (i >> 2) + 4 * n + (i & 3); }

struct Unit { int pm, pn, kt0; };
struct Gemm { const bf16_t* A; const bf16_t* Bt; int M, N, K, nt; };

struct StaticOrder {
    int nM, nN, nwg, G, c, nsplit, nkt;
    __host__ __device__ void init(int M, int N, int G_, int c_) { nM = M / BM; nN = N / BM; nwg = nM * nN; G = G_; c = c_; nsplit = 1; nkt = 0; }
    __host__ __device__ bool next(int i, Unit& u) const {
        const long L0 = (long)i * G + c; const long tot = (long)nwg * nsplit; const bool ok = L0 < tot; const int L = ok ? (int)L0 : 0;
        int pm, pn, kt0;
        if (nsplit > 1) { const int tile = L % nwg, sp = L / nwg; pm = tile / nN; pn = tile % nN; kt0 = sp * nkt; }
        else {
            int wgid = L; { const int q = nwg / NXCD, r = nwg % NXCD, xcd = wgid % NXCD, off = wgid / NXCD; wgid = (xcd < r ? xcd * (q + 1) : r * (q + 1) + (xcd - r) * q) + off; }
            const int nig = WGM * nN, gid = wgid / nig, fm = gid * WGM, gsz = (nM - fm) < WGM ? (nM - fm) : WGM;
            pm = fm + ((wgid % nig) % gsz); pn = (wgid % nig) / gsz; kt0 = 0;
        }
        u.pm = pm; u.pn = pn; u.kt0 = kt0; return ok;
    }
    __device__ __forceinline__ void a_ready(const Unit&) const {}
    __device__ __forceinline__ void done(const Unit&) const {}
};

__device__ __forceinline__ unsigned cvt_pk_bf16(float lo, float hi) { unsigned r; asm volatile("v_cvt_pk_bf16_f32 %0, %1, %2" : "=v"(r) : "v"(lo), "v"(hi)); return r; }
typedef float f32x2 __attribute__((ext_vector_type(2)));

#define PG8_GAS __attribute__((address_space(1)))
struct EpiF32 {
    static constexpr bool PERM = true, AFTER_DRAIN = false;
    float* O; int ldc; const float* res_; float alpha; int split_cols; size_t split_stride; int nkt; size_t kplane;
    __device__ __forceinline__ void operator()(const f32x4 (&acc)[2][2][4][2], const Unit& u, int wr, int wc, int fr, int fq) const {
        const int row0 = u.pm * BM + wr * 64 + fr; int colt = u.pn * BM; float* base = O; const float* res = res_;
        if (nkt) { const int sp = u.kt0 / nkt; base += (size_t)sp * kplane; if (sp) res = nullptr; }
        if (split_cols) { const int t = colt / split_cols; base += (size_t)t * split_stride; colt -= t * split_cols; }
        const int col0 = colt + wc * 32 + 8 * fq;
#pragma unroll
        for (int ai = 0; ai < 2; ++ai)
#pragma unroll
            for (int m = 0; m < 4; ++m) {
                const size_t ro = (size_t)(row0 + ai * HALF + m * 16) * ldc + col0;
#pragma unroll
                for (int bj = 0; bj < 2; ++bj) {
                    f32x4 v0 = acc[ai][bj][m][0], v1 = acc[ai][bj][m][1];
                    if (res) { const f32x4 r0 = *(const PG8_GAS f32x4*)(res + ro + bj * HALF), r1 = *(const PG8_GAS f32x4*)(res + ro + bj * HALF + 4); v0 += r0 * alpha; v1 += r1 * alpha; }
                    *(PG8_GAS f32x4*)(base + ro + bj * HALF) = v0; *(PG8_GAS f32x4*)(base + ro + bj * HALF + 4) = v1;
                }
            }
    }
};
struct EpiSwiGLU {
    static constexpr bool PERM = true, AFTER_DRAIN = false;
    bf16_t* H; int ldh;
    __device__ __forceinline__ void operator()(const f32x4 (&acc)[2][2][4][2], const Unit& u, int wr, int wc, int fr, int fq) const {
        const int row0 = u.pm * BM + wr * 64 + fr; const int hc0 = u.pn * 128 + wc * 16 + 4 * fq;
#pragma unroll
        for (int ai = 0; ai < 2; ++ai)
#pragma unroll
            for (int m = 0; m < 4; ++m) {
                bf16_t* rowp = H + (size_t)(row0 + ai * HALF + m * 16) * ldh + hc0;
#pragma unroll
                for (int bj = 0; bj < 2; ++bj) {
                    const f32x4 g = acc[ai][bj][m][0], up = acc[ai][bj][m][1]; float h[4];
#pragma unroll
                    for (int e = 0; e < 4; ++e) h[e] = g[e] * __builtin_amdgcn_rcpf(1.0f + __expf(-g[e])) * up[e];
                    typedef unsigned u32x2v __attribute__((ext_vector_type(2)));
                    u32x2v w; w.x = cvt_pk_bf16(h[0], h[1]); w.y = cvt_pk_bf16(h[2], h[3]);
                    *(PG8_GAS u32x2v*)(rowp + bj * 64) = w;
                }
            }
    }
};

struct EpiAtomic {
    float* O; int ldc;
    __device__ __forceinline__ void operator()(const f32x4 (&acc)[2][2][4][2], const Unit& u, int wr, int wc, int fr, int fq) const {
        const int row0 = u.pm * BM + wr * 64 + fr; const int col0 = u.pn * BM + wc * 32 + 8 * fq;
#pragma unroll
        for (int ai = 0; ai < 2; ++ai)
#pragma unroll
            for (int m = 0; m < 4; ++m) {
                PG8_GAS float* rp = (PG8_GAS float*)(O + (size_t)(row0 + ai * HALF + m * 16) * ldc + col0);
#pragma unroll
                for (int bj = 0; bj < 2; ++bj)
#pragma unroll
                    for (int n = 0; n < 2; ++n)
#pragma unroll
                        for (int e = 0; e < 4; ++e) __hip_atomic_fetch_add(rp + bj * HALF + 4 * n + e, acc[ai][bj][m][n][e], __ATOMIC_RELAXED, __HIP_MEMORY_SCOPE_AGENT);
            }
    }
};
struct EpiBf16 {
    bf16_t* O; int ld;
    __device__ __forceinline__ void operator()(const f32x4 (&acc)[2][2][4][2], const Unit& u, int wr, int wc, int fr, int fq) const {
        const int row0 = u.pm * BM + wr * 64 + fr; const int col0 = u.pn * BM + wc * 32 + 8 * fq;
#pragma unroll
        for (int ai = 0; ai < 2; ++ai)
#pragma unroll
            for (int m = 0; m < 4; ++m) {
                bf16_t* rowp = O + (size_t)(row0 + ai * HALF + m * 16) * ld + col0;
#pragma unroll
                for (int bj = 0; bj < 2; ++bj) { const f32x4 v0 = acc[ai][bj][m][0], v1 = acc[ai][bj][m][1];
                    u32x4 w; w.x = cvt_pk_bf16(v0[0], v0[1]); w.y = cvt_pk_bf16(v0[2], v0[3]); w.z = cvt_pk_bf16(v1[0], v1[1]); w.w = cvt_pk_bf16(v1[2], v1[3]);
                    *(PG8_GAS u32x4*)(rowp + bj * HALF) = w; }
            }
    }
};
struct EpiBf16Res {
    bf16_t* O; int ld; const float* res; float alpha;
    __device__ __forceinline__ void operator()(const f32x4 (&acc)[2][2][4][2], const Unit& u, int wr, int wc, int fr, int fq) const {
        const int row0 = u.pm * BM + wr * 64 + fr; const int col0 = u.pn * BM + wc * 32 + 8 * fq;
#pragma unroll
        for (int ai = 0; ai < 2; ++ai)
#pragma unroll
            for (int m = 0; m < 4; ++m) {
                const size_t ro = (size_t)(row0 + ai * HALF + m * 16) * ld + col0;
#pragma unroll
                for (int bj = 0; bj < 2; ++bj) {
                    const f32x4 r0 = *(const PG8_GAS f32x4*)(res + ro + bj * HALF), r1 = *(const PG8_GAS f32x4*)(res + ro + bj * HALF + 4);
                    const f32x4 v0 = acc[ai][bj][m][0] + r0 * alpha, v1 = acc[ai][bj][m][1] + r1 * alpha;
                    u32x4 w; w.x = cvt_pk_bf16(v0[0], v0[1]); w.y = cvt_pk_bf16(v0[2], v0[3]); w.z = cvt_pk_bf16(v1[0], v1[1]); w.w = cvt_pk_bf16(v1[2], v1[3]);
                    *(PG8_GAS u32x4*)(O + ro + bj * HALF) = w; }
            }
    }
};
struct EpiGen {
    static constexpr bool PERM = true, AFTER_DRAIN = false;
    int mode; float* O; int ldc; const float* res; float alpha; int split_cols; size_t split_stride; bf16_t* H; int ldh; int nkt; size_t kplane;
    __device__ __forceinline__ void operator()(const f32x4 (&acc)[2][2][4][2], const Unit& u, int wr, int wc, int fr, int fq) const {
        if (mode == 0) { EpiF32 e{O, ldc, res, alpha, split_cols, split_stride, nkt, kplane}; e(acc, u, wr, wc, fr, fq); }
        else if (mode == 1) { EpiSwiGLU e{H, ldh}; e(acc, u, wr, wc, fr, fq); }
        else if (mode == 3) { EpiBf16 e{H, ldh}; e(acc, u, wr, wc, fr, fq); }
        else if (mode == 4) { EpiBf16Res e{H, ldh, res, alpha}; e(acc, u, wr, wc, fr, fq); }
        else { EpiAtomic e{O, ldc}; e(acc, u, wr, wc, fr, fq); }
    }
};
template <class Epi, class Sched, bool ALIGN_EPI = false, bool SP2 = false>
__device__ __forceinline__ void gemm_phase(PG8_LAS unsigned char* lds, const Gemm g, const Sched& S, const Epi& E) {
    int tid_ = threadIdx.x; asm volatile("" : "+v"(tid_));
    const int tid = tid_, wid = __builtin_amdgcn_readfirstlane(tid >> 6), lane = tid & 63, wr = wid >> 2, wc = wid & 3, fr = lane & 15, fq = lane >> 4;
    const int K = g.K, nt = g.nt;
    unsigned voffA[2], voffB[2];
#pragma unroll
    for (int i = 0; i < 2; ++i) { int R, C; stage_rc(tid * 16 + i * 8192, R, C); const int Rb = Epi::PERM ? ((R & ~31) + perm32(R & 31)) : R;
        voffA[i] = (unsigned)(R * K + C) * 2u; voffB[i] = (unsigned)(Rb * K + C) * 2u; }
    const size_t kstep = (size_t)(BK * 2);
    const size_t hstep = (size_t)HALF * K * 2;
    const size_t tstep = 2 * hstep;
    const unsigned ldsw = (unsigned)wid * 1024u;
    const int aoff = lds_byte(wr * 64 + fr, fq * 8), boff = lds_byte(wc * 32 + fr, fq * 8);
#define PG8_SA(b, h) (((b) * 2 + (h)) * HTB)
#define PG8_SB(b, h) ((4 + (b) * 2 + (h)) * HTB)
#define PG8_STAGE(bufoff, gbase, voff) do { _Pragma("unroll") for (int _i = 0; _i < 2; ++_i) \
        __builtin_amdgcn_global_load_lds((const unsigned*)((const char*)(gbase) + (voff)[_i]), (PG8_LAS unsigned*)(lds + (bufoff) + ldsw + _i * 8192), 16, 0, 0); } while (0)
#define PG8_LDA(dst, b, h) do { _Pragma("unroll") for (int m = 0; m < 4; ++m) _Pragma("unroll") for (int k = 0; k < 2; ++k) dst[m][k] = *(const PG8_LAS bf16x8*)(lds + PG8_SA(b, h) + aoff + m * 2048 + k * 1024); } while (0)
#define PG8_LDB(dst, b, h) do { _Pragma("unroll") for (int n = 0; n < 2; ++n) _Pragma("unroll") for (int k = 0; k < 2; ++k) dst[n][k] = *(const PG8_LAS bf16x8*)(lds + PG8_SB(b, h) + boff + n * 2048 + k * 1024); } while (0)
#define PG8_MMA(ai, bj, At, Bt) do { __builtin_amdgcn_s_setprio(1); _Pragma("unroll") for (int m = 0; m < 4; ++m) _Pragma("unroll") for (int n = 0; n < 2; ++n) _Pragma("unroll") for (int k = 0; k < 2; ++k) \
        acc[ai][bj][m][n] = __builtin_amdgcn_mfma_f32_16x16x32_bf16(Bt[n][k], At[m][k], acc[ai][bj][m][n], 0, 0, 0); __builtin_amdgcn_s_setprio(0); } while (0)
#define PG8_WAIT_V(n) asm volatile("s_waitcnt vmcnt(" #n ")" ::: "memory")
#define PG8_WAIT_L(n) asm volatile("s_waitcnt lgkmcnt(" #n ")" ::: "memory")
#define PG8_BAR __builtin_amdgcn_s_barrier()
#define PG8_SCHED __builtin_amdgcn_sched_barrier(0)
    Unit cur, nxt; int ui = 0;
    if (!S.next(0, cur)) return;
    f32x4 acc[2][2][4][2];
#pragma unroll
    for (int a = 0; a < 2; ++a)
#pragma unroll
        for (int b = 0; b < 2; ++b)
#pragma unroll
            for (int m = 0; m < 4; ++m)
#pragma unroll
                for (int n = 0; n < 2; ++n) acc[a][b][m][n] = (f32x4){0.f, 0.f, 0.f, 0.f};
    bf16x8 At[4][2], B0[2][2], B1[2][2];
    const char* cA = (const char*)g.A + (size_t)cur.pm * tstep + (size_t)cur.kt0 * kstep; const char* cB = (const char*)g.Bt + (size_t)cur.pn * tstep + (size_t)cur.kt0 * kstep;
    S.a_ready(cur);
    if constexpr (SP2) {
        PG8_STAGE(PG8_SB(0, 0), cB, voffB); PG8_STAGE(PG8_SB(0, 1), cB + hstep, voffB); PG8_STAGE(PG8_SA(0, 0), cA, voffA); PG8_STAGE(PG8_SA(0, 1), cA + hstep, voffA);
        if (wr == 1) PG8_BAR;
        PG8_WAIT_V(2); PG8_BAR;
        PG8_STAGE(PG8_SB(1, 0), cB + kstep, voffB); PG8_STAGE(PG8_SA(1, 0), cA + kstep, voffA); PG8_STAGE(PG8_SB(1, 1), cB + hstep + kstep, voffB);
        PG8_WAIT_V(6); PG8_BAR;
    } else {
        PG8_STAGE(PG8_SB(0, 0), cB, voffB); PG8_STAGE(PG8_SA(0, 0), cA, voffA); PG8_STAGE(PG8_SB(0, 1), cB + hstep, voffB); PG8_STAGE(PG8_SA(0, 1), cA + hstep, voffA);
        if (wr == 1) PG8_BAR;
        PG8_WAIT_V(4); PG8_BAR;
        PG8_STAGE(PG8_SB(1, 0), cB + kstep, voffB); PG8_STAGE(PG8_SA(1, 0), cA + kstep, voffA); PG8_STAGE(PG8_SB(1, 1), cB + hstep + kstep, voffB);
        PG8_WAIT_V(6); PG8_BAR;
    }
    for (;;) {
        const bool has_next = S.next(ui + 1, nxt);
        const char* nA = has_next ? (const char*)g.A + (size_t)nxt.pm * tstep + (size_t)nxt.kt0 * kstep : cA; const char* nB = has_next ? (const char*)g.Bt + (size_t)nxt.pn * tstep + (size_t)nxt.kt0 * kstep : cB;
        for (int t = 0; t < nt; t += 2) {
            const bool last = (t == nt - 2);
            const char* a1 = cA + (size_t)(t + 1) * kstep;
            const char* a2 = last ? nA : cA + (size_t)(t + 2) * kstep; const char* b2 = last ? nB : cB + (size_t)(t + 2) * kstep;
            const char* a3 = a2 + kstep; const char* b3 = b2 + kstep;
            if (last && has_next) S.a_ready(nxt);
            if constexpr (SP2) {
            PG8_LDB(B0, 0, 0); PG8_LDB(B1, 0, 1); PG8_SCHED; PG8_LDA(At, 0, 0); PG8_STAGE(PG8_SA(1, 1), a1 + hstep, voffA);
            PG8_WAIT_V(8); PG8_WAIT_L(0); PG8_BAR; PG8_MMA(0, 0, At, B0); PG8_MMA(0, 1, At, B1); PG8_BAR; PG8_SCHED;
            PG8_LDA(At, 0, 1); PG8_STAGE(PG8_SB(0, 0), b2, voffB); PG8_STAGE(PG8_SB(0, 1), b2 + hstep, voffB); PG8_STAGE(PG8_SA(0, 0), a2, voffA);
            PG8_WAIT_V(8); PG8_WAIT_L(0); PG8_BAR; PG8_MMA(1, 0, At, B0); PG8_MMA(1, 1, At, B1); PG8_BAR; PG8_SCHED;
            PG8_LDB(B0, 1, 0); PG8_LDB(B1, 1, 1); PG8_SCHED; PG8_LDA(At, 1, 0); PG8_STAGE(PG8_SA(0, 1), a2 + hstep, voffA);
            PG8_WAIT_V(8); PG8_WAIT_L(0); PG8_BAR; PG8_MMA(0, 0, At, B0); PG8_MMA(0, 1, At, B1); PG8_BAR; PG8_SCHED;
            PG8_LDA(At, 1, 1); PG8_STAGE(PG8_SB(1, 0), b3, voffB); PG8_STAGE(PG8_SB(1, 1), b3 + hstep, voffB); PG8_STAGE(PG8_SA(1, 0), a3, voffA);
            PG8_WAIT_V(8); PG8_WAIT_L(0); PG8_BAR; PG8_MMA(1, 0, At, B0); PG8_MMA(1, 1, At, B1); PG8_BAR; PG8_SCHED;
            } else {
            PG8_LDB(B0, 0, 0); PG8_SCHED; PG8_LDA(At, 0, 0); PG8_STAGE(PG8_SA(1, 1), a1 + hstep, voffA);
            PG8_WAIT_L(8); PG8_BAR; PG8_WAIT_L(0); PG8_MMA(0, 0, At, B0); PG8_BAR; PG8_SCHED;
            PG8_LDB(B1, 0, 1); PG8_STAGE(PG8_SB(0, 0), b2, voffB);
            PG8_BAR; PG8_WAIT_L(0); PG8_MMA(0, 1, At, B1); PG8_BAR;
            PG8_LDA(At, 0, 1); PG8_STAGE(PG8_SA(0, 0), a2, voffA);
            PG8_BAR; PG8_WAIT_L(0); PG8_MMA(1, 0, At, B0); PG8_BAR; PG8_SCHED;
            PG8_STAGE(PG8_SB(0, 1), b2 + hstep, voffB);
            PG8_WAIT_V(6); PG8_BAR; PG8_MMA(1, 1, At, B1); PG8_BAR;
            PG8_LDB(B0, 1, 0); PG8_SCHED; PG8_LDA(At, 1, 0); PG8_STAGE(PG8_SA(0, 1), a2 + hstep, voffA);
            PG8_WAIT_L(8); PG8_BAR; PG8_WAIT_L(0); PG8_MMA(0, 0, At, B0); PG8_BAR; PG8_SCHED;
            PG8_LDB(B1, 1, 1); PG8_STAGE(PG8_SB(1, 0), b3, voffB);
            PG8_BAR; PG8_WAIT_L(0); PG8_MMA(0, 1, At, B1); PG8_BAR;
            PG8_LDA(At, 1, 1); PG8_STAGE(PG8_SA(1, 0), a3, voffA);
            PG8_BAR; PG8_WAIT_L(0); PG8_MMA(1, 0, At, B0); PG8_BAR; PG8_SCHED;
            PG8_STAGE(PG8_SB(1, 1), b3 + hstep, voffB);
            PG8_WAIT_V(6); PG8_BAR; PG8_MMA(1, 1, At, B1); PG8_BAR;
            }
        }
        if constexpr (ALIGN_EPI) { if (wr == 0) PG8_BAR; }
        if constexpr (!Epi::AFTER_DRAIN) { E(acc, cur, wr, wc, fr, fq); S.done(cur); }
        if (!has_next) break;
#pragma unroll
        for (int a = 0; a < 2; ++a)
#pragma unroll
            for (int b = 0; b < 2; ++b)
#pragma unroll
                for (int m = 0; m < 4; ++m)
#pragma unroll
                    for (int n = 0; n < 2; ++n) acc[a][b][m][n] = (f32x4){0.f, 0.f, 0.f, 0.f};
        cur = nxt; cA = nA; cB = nB; ++ui;
        if constexpr (ALIGN_EPI) { if (wr == 1) PG8_BAR; }
    }
    PG8_WAIT_V(0);
    if constexpr (!ALIGN_EPI) { if (wr == 0) PG8_BAR; }
    PG8_BAR;
    if constexpr (Epi::AFTER_DRAIN) { E.fused(acc, cur, wr, wc, fr, fq, lds, wid, lane); S.done(cur); }
#undef PG8_SA
#undef PG8_SB
#undef PG8_STAGE
#undef PG8_LDA
#undef PG8_LDB
#undef PG8_MMA
#undef PG8_WAIT_V
#undef PG8_WAIT_L
#undef PG8_BAR
#undef PG8_SCHED
}
}

typedef unsigned short bf16;
typedef float f32x4 __attribute__((ext_vector_type(4)));
typedef float f32x2 __attribute__((ext_vector_type(2)));
typedef short bf16x8 __attribute__((ext_vector_type(8)));
typedef unsigned u32x4 __attribute__((ext_vector_type(4)));
typedef unsigned u32x2 __attribute__((ext_vector_type(2)));

constexpr int NWAVES = 8, NTHR = 512;
constexpr int DM = 2048, NPR = 8192, NSM = 512, MROWS = 8704, SEQ = 2048;
constexpr int RWC = 3328, INC = 7440, PLD = 7680, GD0 = 3328;
constexpr int FF = 5632, XAW = 512;
constexpr float ALPHA = 1.41421356237f;
constexpr int LDS_BYTES = 147456;

constexpr size_t O_YP = 0, O_YS = O_YP + (size_t)NPR * DM, O_PRW = O_YS + (size_t)NSM * DM, O_PSH = O_PRW + 2ull * 4 * 16 * 4096,
    O_PGD = O_PSH + 2ull * 4 * RWC, O_PCV = O_PGD + 2ull * 4 * 8 * 16384, O_PMK = O_PCV + 2ull * 4 * 3 * 3072, O_PMV = O_PMK + 2ull * 4 * 256 * 512,
    O_SRW = O_PMV + 2ull * 4 * 256 * 512, O_SSH = O_SRW + 2ull * 128 * 16 * 4096, O_SGD = O_SSH + 2ull * 128 * RWC, O_SCV = O_SGD + 2ull * 128 * 8 * 16384,
    O_END = O_SCV + 2ull * 128 * 3 * 3072;
static_assert(O_END == 75139072ull, "output size");

constexpr size_t MiB = 1u << 20;
constexpr size_t WS_WIN = 1 * MiB, WS_WOUT = WS_WIN + 30 * MiB, WS_WQ = WS_WOUT + 8 * MiB, WS_WKV = WS_WQ + 2 * MiB, WS_WO = WS_WKV + 4 * MiB,
    WS_WGU = WS_WO + 2 * MiB, WS_WD = WS_WGU + 44 * MiB, WS_LORA = WS_WD + 22 * MiB, WS_X = WS_LORA + 1 * MiB, WS_XB = WS_X + 68 * MiB, WS_MEMB = WS_XB + 34 * MiB,
    WS_P = WS_MEMB + 4 * MiB, WS_SC = WS_P + 255 * MiB, WS_END = WS_SC + 442 * MiB;
constexpr size_t WS_PRE = WS_P;
constexpr size_t W1OFF = WS_P + 128 * MiB - WS_WIN;
static_assert(W1OFF + WS_X <= WS_SC, "second weight set inside the P region");
constexpr size_t SCB = 34 * MiB;
constexpr unsigned SCBF = (unsigned)(SCB / 4);
constexpr size_t WS_R = WS_SC, WS_W = WS_R + SCB, WS_K = WS_W + SCB, WS_V = WS_K + SCB, WS_A = WS_V + SCB, WS_B = WS_A + SCB, WS_G = WS_B + SCB,
    WS_QG = WS_G + SCB, WS_KG = WS_QG + SCB, WS_VG = WS_KG + SCB, WS_BG = WS_VG + SCB, WS_ORW = WS_BG + SCB, WS_OGD = WS_ORW + SCB;
static_assert(WS_OGD + SCB <= WS_END, "scan region");
constexpr size_t WS_MIX = WS_W;
constexpr size_t WS_H = WS_A, WS_Q = WS_QG, WS_AO = WS_KG, WS_PART = WS_VG;
static_assert(94 * MiB <= 3 * SCB && 44 * MiB <= 2 * SCB, "overlays");

__device__ __forceinline__ unsigned f2bf(float f) { unsigned u = __builtin_bit_cast(unsigned, f); return (u + 0x7fffu + ((u >> 16) & 1u)) >> 16; }
__device__ __forceinline__ unsigned pk2(float lo, float hi) { return f2bf(lo) | (f2bf(hi) << 16); }
template <int CTRL> __device__ __forceinline__ float dppf(float x) { return __builtin_bit_cast(float, __builtin_amdgcn_mov_dpp(__builtin_bit_cast(int, x), CTRL, 0xf, 0xf, true)); }
__device__ __forceinline__ float reduce16(float v) {
    v += dppf<0xB1>(v); v += dppf<0x4E>(v); v += dppf<0x141>(v); v += dppf<0x128>(v); return v;
}
__device__ __forceinline__ float reduce8(float v) {
    v += dppf<0xB1>(v); v += dppf<0x4E>(v); v += dppf<0x141>(v); return v;
}
__device__ __forceinline__ float wave_sum(float v) {
    v = reduce16(v); const int iv = __builtin_bit_cast(int, v);
    return (__builtin_bit_cast(float, __builtin_amdgcn_readlane(iv, 0)) + __builtin_bit_cast(float, __builtin_amdgcn_readlane(iv, 16))) +
           (__builtin_bit_cast(float, __builtin_amdgcn_readlane(iv, 32)) + __builtin_bit_cast(float, __builtin_amdgcn_readlane(iv, 48)));
}
#define GAS __attribute__((address_space(1)))
#define LAS __attribute__((address_space(3)))
__device__ __forceinline__ f32x4 ldg4(const float* p) { return *(const GAS f32x4*)p; }
__device__ __forceinline__ float ldg1(const float* p) { return *(const GAS float*)p; }
__device__ __forceinline__ void stg4(float* p, f32x4 v) { *(GAS f32x4*)p = v; }
__device__ __forceinline__ void stg1(float* p, float v) { *(GAS float*)p = v; }
__device__ __forceinline__ void stgb(bf16* p, unsigned v) { *(GAS bf16*)p = (bf16)v; }
__device__ __forceinline__ f32x2 lo2(f32x4 a) { return (f32x2){a.x, a.y}; }
__device__ __forceinline__ f32x2 hi2(f32x4 a) { return (f32x2){a.z, a.w}; }
__device__ __forceinline__ f32x4 ldb4(const bf16* p) { const u32x2 w = *(const GAS u32x2*)p;
    return (f32x4){__builtin_bit_cast(float, w.x << 16), __builtin_bit_cast(float, w.x & 0xffff0000u), __builtin_bit_cast(float, w.y << 16), __builtin_bit_cast(float, w.y & 0xffff0000u)}; }
__device__ __forceinline__ float ldb1(const bf16* p) { return __builtin_bit_cast(float, (unsigned)(*(const GAS bf16*)p) << 16); }
__device__ __forceinline__ float dot4(f32x4 a, f32x4 b) { f32x2 p = lo2(a) * lo2(b); p = __builtin_elementwise_fma(hi2(a), hi2(b), p); return p.x + p.y; }
__device__ __forceinline__ float dot8(f32x4 a0, f32x4 a1, f32x4 b0, f32x4 b1) {
    f32x2 p = lo2(a0) * lo2(b0), q = hi2(a0) * hi2(b0); p = __builtin_elementwise_fma(lo2(a1), lo2(b1), p); q = __builtin_elementwise_fma(hi2(a1), hi2(b1), q); p = p + q; return p.x + p.y; }
__device__ __forceinline__ float rcpf_(float x) { return __builtin_amdgcn_rcpf(x); }
__device__ __forceinline__ float rsqf_(float x) { return __builtin_amdgcn_rsqf(x); }
__device__ __forceinline__ float sigmoidf_(float x) { return rcpf_(1.0f + __expf(-x)); }
__device__ __forceinline__ float softplusf_(float x) { return fmaxf(x, 0.f) + __logf(1.0f + __expf(-fabsf(x))); }
__device__ __forceinline__ float tanhf_(float x) { return 1.0f - 2.0f * rcpf_(1.0f + __expf(2.0f * x)); }
#define LDS_WAIT() asm volatile("s_waitcnt lgkmcnt(0)" ::: "memory")

__device__ __forceinline__ void tr_item(const float* __restrict__ W, int K, int N, bf16* __restrict__ WT, int mode, int row_off, float* scr, int item, int lane) {
    const int nblk = (N + 63) >> 6; const int kb = item / nblk, nb = item - kb * nblk; const int k0 = kb * 64, n0 = nb * 64;
    const int kr = lane >> 4, nc = (lane & 15) * 4; const bool nv = n0 + nc < N;
    f32x4 v[16];
#pragma unroll
    for (int j = 0; j < 16; ++j) v[j] = nv ? ldg4(W + (size_t)(k0 + kr + 4 * j) * N + n0 + nc) : (f32x4){0.f, 0.f, 0.f, 0.f};
#pragma unroll
    for (int j = 0; j < 16; ++j) { float* d = scr + (kr + 4 * j) * 65 + nc; d[0] = v[j].x; d[1] = v[j].y; d[2] = v[j].z; d[3] = v[j].w; }
    LDS_WAIT();
    const int c = lane & 7;
#pragma unroll
    for (int j = 0; j < 8; ++j) {
        const int nn = (lane >> 3) + 8 * j; const float* s = scr + (8 * c) * 65 + nn;
        u32x4 o; o.x = pk2(s[0], s[65]); o.y = pk2(s[2 * 65], s[3 * 65]); o.z = pk2(s[4 * 65], s[5 * 65]); o.w = pk2(s[6 * 65], s[7 * 65]);
        const int ng = n0 + nn;
        if (ng < N) {
            const int drow = mode == 0 ? row_off + ng : ((ng >> 2) * 8 + (mode == 2 ? 4 : 0) + (ng & 3));
            *(GAS u32x4*)(WT + (size_t)drow * K + k0 + 8 * c) = o;
        }
    }
    LDS_WAIT();
}

struct Args { const float* in[39]; float* out; unsigned char* ws; int ph_lo, ph_hi; };
struct LayerW {
    const float *w_in, *w_out, *wq, *wk, *wv, *wo, *wg, *wu, *wd, *w2, *a2, *g2;
};
constexpr int CONV_NIT = 32 * 117 + 32 * 32 + 3 * (32 * 8) + 8 * 32 + 2 * (32 * 88) + 88 * 32 + 2 * 16 + 32;
__device__ __forceinline__ void convert_item(const LayerW& L, unsigned char* ws, float* scr, int it, int lane) {
    constexpr int I_IN = 32 * 117, I_OUT = 32 * 32, I_Q = 32 * 8, I_O = 8 * 32, I_G = 32 * 88, I_D = 88 * 32, I_L = 16;
    bf16* lora = (bf16*)(ws + WS_LORA);
    int r = it;
    if (r < I_IN) { tr_item(L.w_in, DM, INC, (bf16*)(ws + WS_WIN), 0, 0, scr, r, lane); return; } r -= I_IN;
    if (r < I_G) { tr_item(L.wg, DM, FF, (bf16*)(ws + WS_WGU), 1, 0, scr, r, lane); return; } r -= I_G;
    if (r < I_G) { tr_item(L.wu, DM, FF, (bf16*)(ws + WS_WGU), 2, 0, scr, r, lane); return; } r -= I_G;
    if (r < I_D) { tr_item(L.wd, FF, DM, (bf16*)(ws + WS_WD), 0, 0, scr, r, lane); return; } r -= I_D;
    if (r < I_OUT) { tr_item(L.w_out, DM, DM, (bf16*)(ws + WS_WOUT), 0, 0, scr, r, lane); return; } r -= I_OUT;
    if (r < I_Q) { tr_item(L.wq, DM, XAW, (bf16*)(ws + WS_WQ), 0, 0, scr, r, lane); return; } r -= I_Q;
    if (r < I_Q) { tr_item(L.wk, DM, XAW, (bf16*)(ws + WS_WKV), 0, 0, scr, r, lane); return; } r -= I_Q;
    if (r < I_Q) { tr_item(L.wv, DM, XAW, (bf16*)(ws + WS_WKV), 0, 512, scr, r, lane); return; } r -= I_Q;
    if (r < I_O) { tr_item(L.wo, XAW, DM, (bf16*)(ws + WS_WO), 0, 0, scr, r, lane); return; } r -= I_O;
    if (r < I_L) { tr_item(L.w2, 64, 1024, lora, 0, 0, scr, r, lane); return; } r -= I_L;
    if (r < I_L) { tr_item(L.a2, 64, 1024, lora + 65536, 0, 0, scr, r, lane); return; } r -= I_L;
    tr_item(L.g2, 128, 1024, lora + 131072, 0, 0, scr, r, lane);
}
__device__ __forceinline__ void convert_weights(const LayerW& L, unsigned char* ws, float* scr, int gw, int NGW, int lane) {
    for (int it = gw; it < CONV_NIT; it += NGW) convert_item(L, ws, scr, it, lane);
}
__device__ __forceinline__ void row_copy_cvt(const float* src, float* dstf, bf16* dstb, int lane) {
#pragma unroll
    for (int j = 0; j < 8; ++j) {
        const f32x4 v = ldg4(src + 4 * (lane + 64 * j));
        if (dstf) stg4(dstf + 4 * (lane + 64 * j), v);
        u32x2 w; w.x = pk2(v.x, v.y); w.y = pk2(v.z, v.w);
        *((GAS u32x2*)dstb + lane + 64 * j) = w;
    }
}
__device__ __forceinline__ void ln_row(const float* src, const bf16* srcb, int nparts, const float* g, const float* b, float* dstf, bf16* dstb, int lane) {
    f32x4 v[8]; float s = 0.f;
#pragma unroll
    for (int j = 0; j < 8; ++j) v[j] = srcb ? ldb4(srcb + 4 * (lane + 64 * j)) : ldg4(src + 4 * (lane + 64 * j));
    for (int p = 1; p < nparts; ++p) {
#pragma unroll
        for (int j = 0; j < 8; ++j) v[j] += ldg4(src + (size_t)p * (NSM * DM) + 4 * (lane + 64 * j));
    }
#pragma unroll
    for (int j = 0; j < 8; ++j) s += (v[j].x + v[j].y) + (v[j].z + v[j].w);
    const float mean = wave_sum(s) * (1.f / DM); float s2 = 0.f;
#pragma unroll
    for (int j = 0; j < 8; ++j) { v[j] = v[j] - mean; s2 += (v[j].x * v[j].x + v[j].y * v[j].y) + (v[j].z * v[j].z + v[j].w * v[j].w); }
    const float rstd = rsqf_(wave_sum(s2) * (1.f / DM) + 1e-5f);
#pragma unroll
    for (int j = 0; j < 8; ++j) {
        const f32x4 gg = ldg4(g + 4 * (lane + 64 * j)), bb = ldg4(b + 4 * (lane + 64 * j));
        const f32x4 y = v[j] * rstd * gg + bb;
        stg4(dstf + 4 * (lane + 64 * j), y);
        if (dstb) { u32x2 w; w.x = pk2(y.x, y.y); w.y = pk2(y.z, y.w); *((GAS u32x2*)dstb + lane + 64 * j) = w; }
    }
}

struct PrepArgs {
    const bf16* P; const float* state_shift; const float* state_conv;
    const float *mu, *w0, *a0, *kkw, *kaw, *convw, *alog, *dtb;
    const bf16 *W2t, *A2t, *G2t;
    float *R, *W, *K, *V, *A, *B, *G, *QG, *KG, *VG, *BETA, *GDEC;
    float *o_psh, *o_pcv, *o_ssh, *o_scv;
};
__device__ __forceinline__ void prep_rw_unit(const PrepArgs& a, LAS unsigned char* lds, int unit, int tid, int wave, int lane) {
    LAS bf16* A2 = (LAS bf16*)lds;
    LAS float* LL = (LAS float*)(lds + 32 * 264 * 2);
    const int item = unit >> 2, hq = unit & 3; const int m0 = item * 32;
    const int quad = lane >> 4, l15 = lane & 15;
    {
        const int tk = tid >> 4, c0 = (tid & 15) * 16; const int m = m0 + tk;
        const bf16* prow = a.P + (size_t)m * PLD + 3072 + c0;
        const bf16* pprev = prow - PLD; const float* sprev = nullptr; float pm = 1.f;
        if (m < NPR) { if (!(m & (SEQ - 1))) { pprev = prow; pm = 0.f; } }
        else { const int j = m - NPR; if (!(j & 3)) sprev = a.state_shift + (size_t)(j >> 2) * RWC + 3072 + c0; }
        unsigned pk[8];
#pragma unroll
        for (int q4 = 0; q4 < 4; ++q4) {
            const f32x4 p = ldb4(prow + 4 * q4); const f32x4 pv = sprev ? ldg4(sprev + 4 * q4) : ldb4(pprev + 4 * q4) * pm;
            const f32x4 mu = ldg4(a.mu + 3072 + c0 + 4 * q4);
            f32x4 x = p + (pv - p) * mu;
            const int cc = c0 + 4 * q4;
            if (cc < 64) { x.x = tanhf_(x.x); x.y = tanhf_(x.y); x.z = tanhf_(x.z); x.w = tanhf_(x.w); }
            else if (cc >= 128) { x.x = sigmoidf_(x.x); x.y = sigmoidf_(x.y); x.z = sigmoidf_(x.z); x.w = sigmoidf_(x.w); }
            pk[2 * q4] = pk2(x.x, x.y); pk[2 * q4 + 1] = pk2(x.z, x.w);
        }
        LAS u32x4* d = (LAS u32x4*)(A2 + tk * 264 + c0);
        d[0] = (u32x4){pk[0], pk[1], pk[2], pk[3]}; d[1] = (u32x4){pk[4], pk[5], pk[6], pk[7]};
    }
    __syncthreads();
    const int mt = wave & 1, nt = wave >> 1;
    const LAS bf16* arow = A2 + (mt * 16 + l15) * 264 + quad * 8;
    {
        const int h0 = hq * 4;
#pragma unroll
        for (int hh = 0; hh < 4; ++hh) {
            const int n = (h0 + hh) * 64 + nt * 16 + l15;
            f32x4 cw = {0.f, 0.f, 0.f, 0.f}, ca = cw, cg = cw;
#pragma unroll
            for (int ks = 0; ks < 2; ++ks) {
                const bf16x8 av = *(const LAS bf16x8*)(arow + 32 * ks), bv = *(const GAS bf16x8*)(a.W2t + n * 64 + 32 * ks + quad * 8);
                cw = __builtin_amdgcn_mfma_f32_16x16x32_bf16(av, bv, cw, 0, 0, 0);
                const bf16x8 av2 = *(const LAS bf16x8*)(arow + 64 + 32 * ks), bv2 = *(const GAS bf16x8*)(a.A2t + n * 64 + 32 * ks + quad * 8);
                ca = __builtin_amdgcn_mfma_f32_16x16x32_bf16(av2, bv2, ca, 0, 0, 0);
            }
#pragma unroll
            for (int ks = 0; ks < 4; ++ks) {
                const bf16x8 av = *(const LAS bf16x8*)(arow + 128 + 32 * ks), bv = *(const GAS bf16x8*)(a.G2t + n * 128 + 32 * ks + quad * 8);
                cg = __builtin_amdgcn_mfma_f32_16x16x32_bf16(av, bv, cg, 0, 0, 0);
            }
#pragma unroll
            for (int j = 0; j < 4; ++j) {
                const int o = hh * (3 * 32 * 68) + (mt * 16 + quad * 4 + j) * 68 + nt * 16 + l15;
                LL[o] = cw[j]; LL[32 * 68 + o] = ca[j]; LL[2 * 32 * 68 + o] = cg[j];
            }
        }
        __syncthreads();
        {
            const int tk = wave * 4 + (lane >> 4); const int m = m0 + tk;
            const bf16* prow = a.P + (size_t)m * PLD;
            const bf16* pprev = prow - PLD; const float* sprev = nullptr; float pm = 1.f;
            if (m < NPR) { if (!(m & (SEQ - 1))) { pprev = prow; pm = 0.f; } }
            else { const int j = m - NPR; if (!(j & 3)) sprev = a.state_shift + (size_t)(j >> 2) * RWC; }
            f32x4 pr[4], pk_[4], pv[4], qr[4], qk[4], qv[4];
#pragma unroll
            for (int hh = 0; hh < 4; ++hh) { const int col = (h0 + hh) * 64 + 4 * l15;
                pr[hh] = ldb4(prow + col); pk_[hh] = ldb4(prow + 1024 + col); pv[hh] = ldb4(prow + 2048 + col);
                if (sprev) { qr[hh] = ldg4(sprev + col); qk[hh] = ldg4(sprev + 1024 + col); qv[hh] = ldg4(sprev + 2048 + col); }
                else { qr[hh] = ldb4(pprev + col) * pm; qk[hh] = ldb4(pprev + 1024 + col) * pm; qv[hh] = ldb4(pprev + 2048 + col) * pm; } }
#pragma unroll
            for (int hh = 0; hh < 4; ++hh) {
                const int col = (h0 + hh) * 64 + 4 * l15;
                const f32x4 mur = ldg4(a.mu + col), muk = ldg4(a.mu + 1024 + col), muv = ldg4(a.mu + 2048 + col);
                const f32x4 w0 = ldg4(a.w0 + col), a0 = ldg4(a.a0 + col), kkw = ldg4(a.kkw + col), kaw = ldg4(a.kaw + col);
                const LAS float* L0 = LL + hh * (3 * 32 * 68) + tk * 68 + 4 * l15;
                const f32x4 lw4 = *(const LAS f32x4*)L0, la4 = *(const LAS f32x4*)(L0 + 32 * 68), g4 = *(const LAS f32x4*)(L0 + 2 * 32 * 68);
                const f32x4 r4 = pr[hh] + (qr[hh] - pr[hh]) * mur, k4 = pk_[hh] + (qk[hh] - pk_[hh]) * muk, v4 = pv[hh] + (qv[hh] - pv[hh]) * muv;
                const f32x4 kkv = k4 * kkw;
                const float n2 = reduce16(dot4(kkv, kkv)); const float rn = rsqf_(n2 + 1e-12f);
                f32x4 dec, k2, am, bm;
#pragma unroll
                for (int e = 0; e < 4; ++e) {
                    const float lw = lw4[e] + w0[e];
                    const float wlog = -softplusf_(-lw) - 0.5f;
                    dec[e] = __expf(-__expf(wlog));
                    const float av = sigmoidf_(a0[e] + la4[e]);
                    const float kk = kkv[e] * rn;
                    k2[e] = k4[e] * (1.0f + (av - 1.0f) * kaw[e]);
                    am[e] = -kk; bm[e] = kk * av;
                }
                const size_t o = (size_t)m * 1024 + col;
                stg4(a.R + o, r4); stg4(a.W + o, dec); stg4(a.K + o, k2); stg4(a.V + o, v4); stg4(a.A + o, am); stg4(a.B + o, bm); stg4(a.G + o, g4);
            }
        }
        __syncthreads();
    }
}
__device__ __forceinline__ void prep_gd_pair(const PrepArgs& a, int q, int lane) {
    const int m = q >> 2, hp = q & 3; const int h = 2 * hp + (lane >> 5), c4 = 4 * (lane & 31);
    int t, sbase; const float* cprev;
    if (m < NPR) { t = m & (SEQ - 1); sbase = m - t; cprev = nullptr; }
    else { const int j = m - NPR; t = j & 3; sbase = m - t; cprev = a.state_conv + (size_t)(j >> 2) * 3 * 3072; }
    f32x4 acc[3];
#pragma unroll
    for (int s3 = 0; s3 < 3; ++s3) acc[s3] = (f32x4){0.f, 0.f, 0.f, 0.f};
#pragma unroll
    for (int j = 0; j < 4; ++j) {
        const int xi = t + j; const bf16* src = a.P + (size_t)m * PLD + GD0; const float* fsrc = nullptr; float fm = 1.f;
        if (xi >= 3) src = a.P + (size_t)(sbase + xi - 3) * PLD + GD0;
        else if (cprev) fsrc = cprev + (size_t)xi * 3072;
        else fm = 0.f;
#pragma unroll
        for (int s3 = 0; s3 < 3; ++s3) { const int cc = s3 * 1024 + h * 128 + c4; const f32x4 x = fsrc ? ldg4(fsrc + cc) : ldb4(src + cc) * fm; acc[s3] += x * ldg4(a.convw + j * 3072 + cc); }
    }
#pragma unroll
    for (int s3 = 0; s3 < 3; ++s3)
#pragma unroll
        for (int e = 0; e < 4; ++e) { const float x = acc[s3][e]; acc[s3][e] = x * sigmoidf_(x); }
    float qn = reduce16(dot4(acc[0], acc[0])), kn = reduce16(dot4(acc[1], acc[1]));
    qn += __shfl_xor(qn, 16); kn += __shfl_xor(kn, 16);
    const float qs = rsqf_(qn + 1e-12f) * 0.08838834764831845f, ks = rsqf_(kn + 1e-12f);
    const size_t o = (size_t)m * 1024 + h * 128 + c4;
    stg4(a.QG + o, acc[0] * qs); stg4(a.KG + o, acc[1] * ks); stg4(a.VG + o, acc[2]);
    if ((lane & 31) == 0) {
        const float braw = ldb1(a.P + (size_t)m * PLD + GD0 + 4096 + h), araw = ldb1(a.P + (size_t)m * PLD + GD0 + 4104 + h);
        stg1(a.BETA + (size_t)m * 1024 + h * 2, sigmoidf_(braw));
        stg1(a.BETA + (size_t)m * 1024 + h * 2 + 1, __expf(-__expf(ldg1(a.alog + h)) * softplusf_(araw + ldg1(a.dtb + h))));
    }
}
__device__ __forceinline__ void prep_copy_unit(const PrepArgs& a, int u, int lane) {
    const bf16* src; float* dst; int n4;
    if (u < 396) { const int seq = u / 3, i = u - seq * 3; n4 = 768;
        if (seq < 4) { src = a.P + (size_t)(seq * SEQ + SEQ - 3 + i) * PLD + GD0; dst = a.o_pcv + (size_t)(seq * 3 + i) * 3072; }
        else { const int b = seq - 4; src = a.P + (size_t)(NPR + 4 * b + 1 + i) * PLD + GD0; dst = a.o_scv + (size_t)(b * 3 + i) * 3072; } }
    else { const int v = u - 396; n4 = 832;
        if (v < 4) { src = a.P + (size_t)(v * SEQ + SEQ - 1) * PLD; dst = a.o_psh + (size_t)v * RWC; }
        else { const int b = v - 4; src = a.P + (size_t)(NPR + 4 * b + 3) * PLD; dst = a.o_ssh + (size_t)b * RWC; } }
    for (int c = lane; c < n4; c += 64) stg4(dst + 4 * c, ldb4(src + 4 * c));
}

struct ScanArgs {
    const float *R, *W, *K, *V, *A, *B, *QG, *KG, *VG, *BETA, *GDEC;
    const float *st_rw, *st_gd;
    float *ORW, *OGD;
    float *o_prw, *o_pgd, *o_srw, *o_sgd;
};
constexpr int TC = 16, RW_STEP = 336, GD_STEP = 276, SC_BUF = TC * (RW_STEP + GD_STEP);
__device__ __forceinline__ unsigned sc_slot(bool rw, int i, int t2, int m0, int h, int part) {
    const int idx = t2 + 256 * i; unsigned eo = 0u;
    if (rw) {
        if (idx < TC * 84) {
            const int stp = idx / 84, f4 = idx - stp * 84; const int vec = f4 >> 4, o4 = (f4 & 15) * 4;
            const unsigned arr = vec == 0 ? 1u : vec == 1 ? 4u : vec == 2 ? 5u : vec == 3 ? 2u : vec == 4 ? 0u : 3u;
            eo = arr * SCBF + (unsigned)(m0 + stp) * 1024u + h * 64 + (vec == 5 ? part * 16 + o4 : o4);
        }
    } else {
        if (i < 5 && idx < TC * 69) {
            const int stp = idx / 69, f4 = idx - stp * 69; const unsigned rb = (unsigned)(m0 + stp) * 1024u;
            if (f4 < 32) eo = 8u * SCBF + rb + h * 128 + f4 * 4;
            else if (f4 < 64) eo = 7u * SCBF + rb + h * 128 + (f4 - 32) * 4;
            else if (f4 < 68) eo = 9u * SCBF + rb + h * 128 + part * 16 + (f4 - 64) * 4;
            else eo = 10u * SCBF + rb + h * 2;
        }
    }
    return eo * 4u;
}
__device__ __forceinline__ f32x4 sc_load(const float* base, unsigned boff, int c) {
    return *(const GAS f32x4*)((const GAS char*)base + (boff + (unsigned)c * (TC * 1024u * 4u)));
}
__device__ __forceinline__ void sc_store(LAS float* bf, bool rw, int i, int t2, f32x4 v) {
    const int idx = t2 + 256 * i;
    if (rw) { if (idx < TC * 84) { const int stp = idx / 84, f4 = idx - stp * 84; *(LAS f32x4*)(bf + stp * RW_STEP + f4 * 4) = v; } }
    else { if (i < 5 && idx < TC * 69) { const int stp = idx / 69, f4 = idx - stp * 69; *(LAS f32x4*)(bf + TC * RW_STEP + stp * GD_STEP + f4 * 4) = v; } }
}
template <int NI> __device__ __forceinline__ void scan_sample_rw(const ScanArgs& a, int q, int lane) {
    const int grp16 = lane >> 4, l15 = lane & 15, ks = l15 * 4;
    f32x4 s[NI], w[NI][4], av[NI][4], bv[NI][4], kv[NI][4], rv[NI][4]; float vv[NI][4]; size_t so[NI]; int m0[NI], oc[NI];
#pragma unroll
    for (int ii = 0; ii < NI; ++ii) {
        const int j = NI * q + ii; const int bh = j >> 4, g = j & 15; const int b = bh >> 4, h = bh & 15; const int row = 4 * g + grp16;
        m0[ii] = NPR + 4 * b; oc[ii] = h * 64 + row; so[ii] = (size_t)bh * 4096 + row * 64 + ks;
        s[ii] = ldg4(a.st_rw + so[ii]);
#pragma unroll
        for (int t = 0; t < 4; ++t) { const size_t o = (size_t)(m0[ii] + t) * 1024 + h * 64;
            w[ii][t] = ldg4(a.W + o + ks); av[ii][t] = ldg4(a.A + o + ks); bv[ii][t] = ldg4(a.B + o + ks); kv[ii][t] = ldg4(a.K + o + ks); rv[ii][t] = ldg4(a.R + o + ks); vv[ii][t] = ldg1(a.V + o + row); }
    }
#pragma unroll
    for (int ii = 0; ii < NI; ++ii) {
        float osave = 0.f;
#pragma unroll
        for (int t = 0; t < 4; ++t) {
            const float sa = reduce16(dot4(s[ii], av[ii][t]));
            s[ii] = s[ii] * w[ii][t] + (bv[ii][t] * sa + kv[ii][t] * vv[ii][t]);
            const float o = reduce16(dot4(s[ii], rv[ii][t]));
            osave = (l15 == t) ? o : osave;
        }
        if (l15 < 4) stg1(a.ORW + (size_t)(m0[ii] + l15) * 1024 + oc[ii], osave);
        stg4(a.o_srw + so[ii], s[ii]);
    }
}
template <int NI> __device__ __forceinline__ void scan_sample_gd(const ScanArgs& a, int q, int lane) {
    const int grp16 = lane >> 4, l15 = lane & 15, ks = l15 * 8;
    f32x4 s0[NI], s1[NI], k0[NI][4], k1[NI][4], q0[NI][4], q1[NI][4]; float vv[NI][4], be[NI][4], gd[NI][4]; size_t so[NI]; int m0[NI], oc[NI];
#pragma unroll
    for (int ii = 0; ii < NI; ++ii) {
        const int j = NI * q + ii; const int bh = j >> 5, g = j & 31; const int b = bh >> 3, h = bh & 7; const int col = 4 * g + grp16;
        m0[ii] = NPR + 4 * b; oc[ii] = h * 128 + col; so[ii] = (size_t)bh * 16384 + (size_t)ks * 128 + col;
        const float* sp = a.st_gd + so[ii];
        s0[ii] = (f32x4){ldg1(sp), ldg1(sp + 128), ldg1(sp + 256), ldg1(sp + 384)}; s1[ii] = (f32x4){ldg1(sp + 512), ldg1(sp + 640), ldg1(sp + 768), ldg1(sp + 896)};
#pragma unroll
        for (int t = 0; t < 4; ++t) { const int m = m0[ii] + t; const size_t o = (size_t)m * 1024 + h * 128;
            k0[ii][t] = ldg4(a.KG + o + ks); k1[ii][t] = ldg4(a.KG + o + ks + 4); q0[ii][t] = ldg4(a.QG + o + ks); q1[ii][t] = ldg4(a.QG + o + ks + 4);
            vv[ii][t] = ldg1(a.VG + o + col); be[ii][t] = ldg1(a.BETA + (size_t)m * 1024 + h * 2); gd[ii][t] = ldg1(a.BETA + (size_t)m * 1024 + h * 2 + 1); }
    }
#pragma unroll
    for (int ii = 0; ii < NI; ++ii) {
        float osave = 0.f;
#pragma unroll
        for (int t = 0; t < 4; ++t) {
            const float d = reduce16(dot8(s0[ii], s1[ii], k0[ii][t], k1[ii][t]));
            const float gdec = gd[ii][t]; const float cc = be[ii][t] * (vv[ii][t] - gdec * d);
            s0[ii] = s0[ii] * gdec + k0[ii][t] * cc; s1[ii] = s1[ii] * gdec + k1[ii][t] * cc;
            const float o = reduce16(dot8(s0[ii], s1[ii], q0[ii][t], q1[ii][t]));
            osave = (l15 == t) ? o : osave;
        }
        if (l15 < 4) stg1(a.OGD + (size_t)(m0[ii] + l15) * 1024 + oc[ii], osave);
        float* sp = a.o_sgd + so[ii];
        stg1(sp, s0[ii].x); stg1(sp + 128, s0[ii].y); stg1(sp + 256, s0[ii].z); stg1(sp + 384, s0[ii].w);
        stg1(sp + 512, s1[ii].x); stg1(sp + 640, s1[ii].y); stg1(sp + 768, s1[ii].z); stg1(sp + 896, s1[ii].w);
    }
}

__device__ __forceinline__ void scan_prompt(const ScanArgs& a, LAS unsigned char* lds, int it, int tid, int wave, int lane, int hw, bool conv, const Args& args, unsigned char* convdst) {
    LAS float* buf = (LAS float*)lds;
    const bool rw = tid < 256; const int t2 = tid & 255;
    const int l15 = lane & 15, grp16 = lane >> 4;
    const int bh_r = it >> 2, part_r = it & 3, b_r = bh_r >> 4, h_r = bh_r & 15;
    const int bh_g = it >> 3, part_g = it & 7, b_g = bh_g >> 3, h_g = bh_g & 7;
    const int m0l = (rw ? b_r : b_g) * SEQ, hl = rw ? h_r : h_g, partl = rw ? part_r : part_g;
    unsigned e0 = sc_slot(rw, 0, t2, m0l, hl, partl); asm volatile("" : "+v"(e0));
    unsigned e1 = sc_slot(rw, 1, t2, m0l, hl, partl); asm volatile("" : "+v"(e1));
    unsigned e2 = sc_slot(rw, 2, t2, m0l, hl, partl); asm volatile("" : "+v"(e2));
    unsigned e3 = sc_slot(rw, 3, t2, m0l, hl, partl); asm volatile("" : "+v"(e3));
    unsigned e4 = sc_slot(rw, 4, t2, m0l, hl, partl); asm volatile("" : "+v"(e4));
    unsigned e5 = sc_slot(rw, 5, t2, m0l, hl, partl); asm volatile("" : "+v"(e5));
    constexpr int nch = SEQ / TC;
    f32x4 st0, st1, st2, st3, st4, st5;
#define SC_LOAD_ALL(c_) do { const int cc_ = (c_); st0 = sc_load(a.R, e0, cc_); st1 = sc_load(a.R, e1, cc_); st2 = sc_load(a.R, e2, cc_); st3 = sc_load(a.R, e3, cc_); st4 = sc_load(a.R, e4, cc_); st5 = sc_load(a.R, e5, cc_); } while (0)
#define SC_STORE_ALL(bf_) do { LAS float* b_ = (bf_); sc_store(b_, rw, 0, t2, st0); sc_store(b_, rw, 1, t2, st1); sc_store(b_, rw, 2, t2, st2); sc_store(b_, rw, 3, t2, st3); sc_store(b_, rw, 4, t2, st4); sc_store(b_, rw, 5, t2, st5); } while (0)
    f32x4 sa0 = {0.f, 0.f, 0.f, 0.f}, sa1 = sa0, sb0 = sa0, sb1 = sa0;
    const int cw = wave & 1;
    const int rl = cw * 8 + grp16 * 2;
    const int rc = (wave < 2 ? part_g : part_r) * 16 + rl;
    SC_LOAD_ALL(0); SC_STORE_ALL(buf); __syncthreads();
    if (wave < 4) __builtin_amdgcn_s_setprio(3);
    for (int c = 0; c < nch; ++c) {
        LAS float* cur = buf + (c & 1) * SC_BUF;
        if (c + 1 < nch) SC_LOAD_ALL(c + 1);
        float* op = nullptr; f32x2 ov = {0.f, 0.f};
        if (wave >= 4) {
            int lane2 = lane; asm volatile("" : "+v"(lane2));
            if (c & 1) { const int u = hw + 1024 * (c >> 1); if (u < 32768) scan_sample_rw<1>(a, u, lane2); else scan_sample_gd<1>(a, u - 32768, lane2); }
            if (conv && (c & 7) == 2 && c < 112) { const int ci = hw + 1024 * (c >> 3);
#define INL(i) ({ int _i = (i); asm volatile("" : "+s"(_i)); args.in[_i]; })
                const LayerW L1{INL(9) + (size_t)DM * INC, INL(25) + (size_t)DM * DM, INL(28) + (size_t)DM * XAW, INL(29) + (size_t)DM * XAW, INL(30) + (size_t)DM * XAW,
                                INL(31) + (size_t)XAW * DM, INL(34) + (size_t)DM * FF, INL(35) + (size_t)DM * FF, INL(36) + (size_t)FF * DM, INL(12) + 65536, INL(14) + 65536, INL(15) + 131072};
                if (ci < CONV_NIT) convert_item(L1, convdst, (float*)((unsigned char*)lds + 2 * SC_BUF * 4) + (wave - 4) * 4160, ci, lane2); }
        } else if (wave == 2 || wave == 3) {
            const LAS float* bs = cur + l15 * 4; const LAS float* bv = cur + 320 + rl;
            float osa = 0.f, osb = 0.f;
            f32x4 w4 = *(const LAS f32x4*)bs, a4 = *(const LAS f32x4*)(bs + 64), b4 = *(const LAS f32x4*)(bs + 128), k4 = *(const LAS f32x4*)(bs + 192), r4 = *(const LAS f32x4*)(bs + 256);
            f32x2 vv = *(const LAS f32x2*)bv;
#pragma unroll
            for (int stp = 0; stp < TC; ++stp) {
                f32x4 nw = w4, na = a4, nb = b4, nk = k4, nr = r4; f32x2 nv = vv;
                if (stp + 1 < TC) { const LAS float* p = bs + (stp + 1) * RW_STEP;
                    nw = *(const LAS f32x4*)p; na = *(const LAS f32x4*)(p + 64); nb = *(const LAS f32x4*)(p + 128); nk = *(const LAS f32x4*)(p + 192); nr = *(const LAS f32x4*)(p + 256); nv = *(const LAS f32x2*)(bv + (stp + 1) * RW_STEP); }
                const float da = reduce16(dot4(sa0, a4)), db = reduce16(dot4(sb0, a4));
                sa0 = sa0 * w4 + (b4 * da + k4 * vv.x); sb0 = sb0 * w4 + (b4 * db + k4 * vv.y);
                const float oa = reduce16(dot4(sa0, r4)), ob = reduce16(dot4(sb0, r4));
                osa = (l15 == stp) ? oa : osa; osb = (l15 == stp) ? ob : osb;
                w4 = nw; a4 = na; b4 = nb; k4 = nk; r4 = nr; vv = nv;
            }
            op = a.ORW + (size_t)(b_r * SEQ + c * TC + l15) * 1024 + h_r * 64 + rc; ov = (f32x2){osa, osb};
        } else if (wave < 2) {
            const LAS float* bs = cur + TC * RW_STEP + l15 * 8; const LAS float* bv = cur + TC * RW_STEP + 256 + rl; const LAS float* bg = cur + TC * RW_STEP + 272;
            float osa = 0.f, osb = 0.f;
            f32x4 k0 = *(const LAS f32x4*)bs, k1 = *(const LAS f32x4*)(bs + 4), q0 = *(const LAS f32x4*)(bs + 128), q1 = *(const LAS f32x4*)(bs + 132);
            f32x2 vv = *(const LAS f32x2*)bv; f32x2 bg2 = *(const LAS f32x2*)bg;
#pragma unroll
            for (int stp = 0; stp < TC; ++stp) {
                f32x4 nk0 = k0, nk1 = k1, nq0 = q0, nq1 = q1; f32x2 nv = vv; f32x2 nbg = bg2;
                if (stp + 1 < TC) { const LAS float* p = bs + (stp + 1) * GD_STEP;
                    nk0 = *(const LAS f32x4*)p; nk1 = *(const LAS f32x4*)(p + 4); nq0 = *(const LAS f32x4*)(p + 128); nq1 = *(const LAS f32x4*)(p + 132); nv = *(const LAS f32x2*)(bv + (stp + 1) * GD_STEP); nbg = *(const LAS f32x2*)(bg + (stp + 1) * GD_STEP); }
                const float da = reduce16(dot8(sa0, sa1, k0, k1)), db = reduce16(dot8(sb0, sb1, k0, k1));
                const float gdec = bg2.y; const float ca = bg2.x * (vv.x - gdec * da), cb = bg2.x * (vv.y - gdec * db);
                sa0 = sa0 * gdec + k0 * ca; sa1 = sa1 * gdec + k1 * ca; sb0 = sb0 * gdec + k0 * cb; sb1 = sb1 * gdec + k1 * cb;
                const float oa = reduce16(dot8(sa0, sa1, q0, q1)), ob = reduce16(dot8(sb0, sb1, q0, q1));
                osa = (l15 == stp) ? oa : osa; osb = (l15 == stp) ? ob : osb;
                k0 = nk0; k1 = nk1; q0 = nq0; q1 = nq1; vv = nv; bg2 = nbg;
            }
            op = a.OGD + (size_t)(b_g * SEQ + c * TC + l15) * 1024 + h_g * 128 + rc; ov = (f32x2){osa, osb};
        }
        if (c + 1 < nch) SC_STORE_ALL(buf + ((c + 1) & 1) * SC_BUF);
        if (wave < 4) *(GAS f32x2*)op = ov;
        asm volatile("s_waitcnt lgkmcnt(0)" ::: "memory"); __builtin_amdgcn_s_barrier(); asm volatile("" ::: "memory");
    }
    __builtin_amdgcn_s_setprio(0);
    if (wave == 2 || wave == 3) { float* sp = a.o_prw + (size_t)bh_r * 4096 + rc * 64 + l15 * 4; stg4(sp, sa0); stg4(sp + 64, sb0); }
    else if (wave < 2) { float* sp = a.o_pgd + (size_t)bh_g * 16384 + (size_t)(l15 * 8) * 128 + rc;
#pragma unroll
        for (int e = 0; e < 4; ++e) { *(GAS f32x2*)(sp + (size_t)e * 128) = (f32x2){sa0[e], sb0[e]}; *(GAS f32x2*)(sp + (size_t)(4 + e) * 128) = (f32x2){sa1[e], sb1[e]}; } }
}

struct PostArgs {
    const bf16* P; const float *R, *K, *V, *G, *ORW, *OGD; const float *rk, *lnxw, *lnxb, *normw; bf16* MIX;
};
__device__ __forceinline__ void post_row(const PostArgs& a, int m, int lane) {
    const size_t rb = (size_t)m * 1024;
    f32x4 o[4], r[4], k[4], v[4], g[4];
#pragma unroll
    for (int j = 0; j < 4; ++j) { const int col = j * 256 + 4 * lane;
        o[j] = ldg4(a.ORW + rb + col); r[j] = ldg4(a.R + rb + col); k[j] = ldg4(a.K + rb + col); v[j] = ldg4(a.V + rb + col); g[j] = ldg4(a.G + rb + col); }
#pragma unroll
    for (int j = 0; j < 4; ++j) { const int col = j * 256 + 4 * lane;
        const f32x4 lw = ldg4(a.lnxw + col), lb = ldg4(a.lnxb + col), rk = ldg4(a.rk + col);
        const float mu = reduce16((o[j].x + o[j].y) + (o[j].z + o[j].w)) * (1.f / 64.f); const f32x4 d = o[j] - mu;
        const float var = reduce16(dot4(d, d)) * (1.f / 64.f); const float rs = rsqf_(var + 64e-5f);
        const float bs = reduce16(dot4(r[j] * k[j], rk));
        const f32x4 y = (d * rs * lw + lb + v[j] * bs) * g[j];
        u32x2 w; w.x = pk2(y.x, y.y); w.y = pk2(y.z, y.w);
        *(GAS u32x2*)(a.MIX + (size_t)m * DM + col) = w; }
    f32x4 og[4], z[4];
#pragma unroll
    for (int j = 0; j < 4; ++j) { const int col = j * 256 + 4 * lane; og[j] = ldg4(a.OGD + rb + col); z[j] = ldb4(a.P + (size_t)m * PLD + GD0 + 3072 + col); }
    const f32x4 nw = ldg4(a.normw + 4 * (lane & 31));
#pragma unroll
    for (int j = 0; j < 4; ++j) { const int col = j * 256 + 4 * lane;
        float ms = reduce16(dot4(og[j], og[j])); ms += __shfl_xor(ms, 16); const float rs = rsqf_(ms * (1.f / 128.f) + 1e-6f);
        f32x4 y;
#pragma unroll
        for (int e = 0; e < 4; ++e) y[e] = og[j][e] * rs * nw[e] * (z[j][e] * sigmoidf_(z[j][e]));
        u32x2 w; w.x = pk2(y.x, y.y); w.y = pk2(y.z, y.w);
        *(GAS u32x2*)(a.MIX + (size_t)m * DM + 1024 + col) = w; }
}

constexpr int KP = 136, VP = 132;
__device__ __forceinline__ void attn_unit(const float* Kp, const float* Vp, const float* Q, bf16* AO, int mrow0, int nvalid, bool all_waves, int hcol,
                                          unsigned char* lds, int tid, int wave, int lane) {
    bf16* Ks = (bf16*)lds; bf16* Vs = Ks + 256 * KP;
#pragma unroll
    for (int i0 = 0; i0 < 16; i0 += 8) {
        f32x4 kk8[8], vv8[8];
#pragma unroll
        for (int j = 0; j < 8; ++j) { const int idx = tid + NTHR * (i0 + j); const int key = idx >> 5, d4 = (idx & 31) * 4;
            kk8[j] = ldg4(Kp + (size_t)key * 512 + d4); vv8[j] = ldg4(Vp + (size_t)key * 512 + d4); }
#pragma unroll
        for (int j = 0; j < 8; ++j) { const int idx = tid + NTHR * (i0 + j); const int key = idx >> 5, d4 = (idx & 31) * 4;
            const f32x4 kv = kk8[j], vv = vv8[j];
            u32x2 a, b; a.x = pk2(kv.x, kv.y); a.y = pk2(kv.z, kv.w); b.x = pk2(vv.x, vv.y); b.y = pk2(vv.z, vv.w);
            *(u32x2*)(Ks + key * KP + d4) = a; *(u32x2*)(Vs + key * VP + d4) = b; }
    }
    __syncthreads();
    if (all_waves || wave == 0) {
        const int quad = lane >> 4, l15 = lane & 15;
        const int qr = (all_waves ? wave * 16 : 0) + l15; const bool valid = qr < nvalid; const int m = mrow0 + qr;
        bf16x8 qf[4];
#pragma unroll
        for (int ds = 0; ds < 4; ++ds) {
            f32x4 x0 = {0.f, 0.f, 0.f, 0.f}, x1 = x0;
            if (valid) { const float* qp = Q + (size_t)m * XAW + hcol + 32 * ds + quad * 8; x0 = ldg4(qp); x1 = ldg4(qp + 4); }
            u32x4 w; w.x = pk2(x0.x, x0.y); w.y = pk2(x0.z, x0.w); w.z = pk2(x1.x, x1.y); w.w = pk2(x1.z, x1.w);
            qf[ds] = __builtin_bit_cast(bf16x8, w);
        }
        f32x4 sc[16];
#pragma unroll
        for (int kt = 0; kt < 16; ++kt) {
            sc[kt] = (f32x4){0.f, 0.f, 0.f, 0.f};
#pragma unroll
            for (int ds = 0; ds < 4; ++ds) {
                const bf16x8 kf = *(const bf16x8*)(Ks + (16 * kt + l15) * KP + 32 * ds + quad * 8);
                sc[kt] = __builtin_amdgcn_mfma_f32_16x16x32_bf16(kf, qf[ds], sc[kt], 0, 0, 0);
            }
        }
        float mx = -3.0e38f;
#pragma unroll
        for (int kt = 0; kt < 16; ++kt) mx = fmaxf(mx, fmaxf(fmaxf(sc[kt].x, sc[kt].y), fmaxf(sc[kt].z, sc[kt].w)));
        mx = fmaxf(mx, __shfl_xor(mx, 16)); mx = fmaxf(mx, __shfl_xor(mx, 32));
        const float c2 = 0.08838834764831845f * 1.4426950408889634f; float sum = 0.f;
        bf16x8 pb[8];
#pragma unroll
        for (int ks = 0; ks < 8; ++ks) {
            float p[8];
#pragma unroll
            for (int e = 0; e < 4; ++e) { p[e] = exp2f((sc[2 * ks][e] - mx) * c2); p[4 + e] = exp2f((sc[2 * ks + 1][e] - mx) * c2); }
            sum += ((p[0] + p[1]) + (p[2] + p[3])) + ((p[4] + p[5]) + (p[6] + p[7]));
            u32x4 w; w.x = pk2(p[0], p[1]); w.y = pk2(p[2], p[3]); w.z = pk2(p[4], p[5]); w.w = pk2(p[6], p[7]);
            pb[ks] = __builtin_bit_cast(bf16x8, w);
        }
        sum += __shfl_xor(sum, 16); sum += __shfl_xor(sum, 32);
        const float inv = rcpf_(sum);
#pragma unroll
        for (int nt = 0; nt < 8; ++nt) {
            f32x4 o = {0.f, 0.f, 0.f, 0.f};
            const bf16* vcol = Vs + 16 * nt + l15;
#pragma unroll
            for (int ks = 0; ks < 8; ++ks) {
                const bf16* v0 = vcol + (32 * ks + 4 * quad) * VP; const bf16* v1 = v0 + 16 * VP;
                u32x4 w;
                w.x = (unsigned)v0[0] | ((unsigned)v0[VP] << 16); w.y = (unsigned)v0[2 * VP] | ((unsigned)v0[3 * VP] << 16);
                w.z = (unsigned)v1[0] | ((unsigned)v1[VP] << 16); w.w = (unsigned)v1[2 * VP] | ((unsigned)v1[3 * VP] << 16);
                o = __builtin_amdgcn_mfma_f32_16x16x32_bf16(__builtin_bit_cast(bf16x8, w), pb[ks], o, 0, 0, 0);
            }
            if (valid) { u32x2 w; w.x = pk2(o.x * inv, o.y * inv); w.y = pk2(o.z * inv, o.w * inv); *(GAS u32x2*)(AO + (size_t)m * XAW + hcol + 16 * nt + quad * 4) = w; }
        }
    }
    __syncthreads();
}

#define RLX_AGENT __ATOMIC_RELAXED, __HIP_MEMORY_SCOPE_AGENT
#define XB_TMO      128
#define XB_XCNT(j)  (256  + 64 * (j))
#define XB_XSUB(j)  (1280 + 64 * (j))
#define XB_XGEN(j)  (2304 + 64 * (j))
#define XB_TOP      3328
#define XB_TOPGEN   3392
#define XCD_BAR_WORDS 3456
#define XB_SPIN_CAP (1u << 18)

__device__ __forceinline__ unsigned xb_ld(unsigned* p)              { return __hip_atomic_load(p, __ATOMIC_RELAXED, __HIP_MEMORY_SCOPE_AGENT); }
__device__ __forceinline__ unsigned xb_add(unsigned* p, unsigned v) { return __hip_atomic_fetch_add(p, v, __ATOMIC_RELAXED, __HIP_MEMORY_SCOPE_AGENT); }
__device__ __forceinline__ unsigned xb_xcc_id() { return (unsigned)__builtin_amdgcn_s_getreg((3 << 11) | 20) & 0xFu; }
#define XB_SPIN(cond, bar) do { unsigned _sp = 0; while (cond) { __builtin_amdgcn_s_sleep(1); \
    if ((++_sp & 255u) == 0u) { if (xb_ld(&(bar)[XB_TMO])) break; if (_sp > XB_SPIN_CAP) { atomicAdd(&(bar)[XB_TMO], 1u); break; } } } } while (0)

struct XcdBarrier {
    unsigned* bar; unsigned x;
    volatile LAS unsigned* st;
};

__device__ __forceinline__ XcdBarrier xcd_barrier_post(unsigned* bar, volatile LAS unsigned* st) {
    XcdBarrier b; b.bar = bar; b.x = xb_xcc_id(); b.st = st;
    if (threadIdx.x == 0) (void)xb_add(&bar[XB_XCNT(b.x)], 1u);
    return b;
}
__device__ __forceinline__ void xcd_barrier_complete(unsigned* bar, unsigned x, unsigned& nloc, unsigned& nx) {
    const unsigned G = gridDim.x * gridDim.y * gridDim.z;
    unsigned sum, cnt, mine, sp = 0u;
    for (;;) {
        sum = 0u; cnt = 0u; mine = 0u;
#pragma unroll
        for (unsigned j = 0; j < 16; ++j) { const unsigned c = xb_ld(&bar[XB_XCNT(j)]); sum += c; cnt += (c > 0u) ? 1u : 0u; mine = (j == x) ? c : mine; }
        if (sum == G) break;
        __builtin_amdgcn_s_sleep(1);
        if ((++sp & 255u) == 0u) { if (xb_ld(&bar[XB_TMO])) break; if (sp > XB_SPIN_CAP) { atomicAdd(&bar[XB_TMO], 1u); break; } }
    }
    nloc = mine > 0u ? mine : 1u; nx = cnt > 0u ? cnt : 1u;
}

__device__ __forceinline__ void xcd_barrier(const XcdBarrier& b) {
    asm volatile("s_waitcnt vmcnt(0)" ::: "memory");
    __syncthreads();
    if (threadIdx.x == 0) {
        unsigned* bar = b.bar;
        __builtin_amdgcn_s_waitcnt(0);
        unsigned nloc = b.st[0], nx = b.st[1];
        if (nloc == 0u) { xcd_barrier_complete(bar, b.x, nloc, nx); b.st[0] = nloc; b.st[1] = nx; }
        const unsigned old = xb_add(&bar[XB_XSUB(b.x)], 1u);
        const unsigned gen = old / nloc;
        if (old + 1u == (gen + 1u) * nloc) {
            __builtin_amdgcn_fence(__ATOMIC_RELEASE, "agent");
            asm volatile("s_waitcnt vmcnt(0)" ::: "memory");
            const unsigned og = xb_add(&bar[XB_TOP], 1u);
            const unsigned tg = og / nx;
            if (og + 1u == (tg + 1u) * nx) xb_add(&bar[XB_TOPGEN], 1u);
            else XB_SPIN(xb_ld(&bar[XB_TOPGEN]) == tg, bar);
            __builtin_amdgcn_fence(__ATOMIC_ACQUIRE, "agent");
            xb_add(&bar[XB_XGEN(b.x)], 1u);
            asm volatile("s_waitcnt vmcnt(0)" ::: "memory");
        } else {
            XB_SPIN(xb_ld(&bar[XB_XGEN(b.x)]) == gen, bar);
            __builtin_amdgcn_fence(__ATOMIC_ACQUIRE, "agent");
            asm volatile("s_waitcnt vmcnt(0)" ::: "memory");
        }
    }
    __syncthreads();
}

constexpr int NPHASE = 27;

#ifndef DUP_MASK
#define DUP_MASK 0
#endif
#ifndef SAMPLE_REPS
#define SAMPLE_REPS 1
#endif
__global__ void __launch_bounds__(NTHR, 2) fwd_megakernel(Args args) {
    extern __shared__ __attribute__((aligned(16))) unsigned char lds[];
    cg::grid_group grid = cg::this_grid();
    const int G = gridDim.x, bx = blockIdx.x;
    const int lo = args.ph_lo, hi = args.ph_hi;
#define IN(i) ({ int _i = (i); asm volatile("" : "+s"(_i)); args.in[_i]; })

    unsigned* barw = (unsigned*)(args.ws + 16384);
    volatile LAS unsigned* MISC = (volatile LAS unsigned*)((LAS unsigned char*)lds + (LDS_BYTES - 64));
    if (threadIdx.x < 16) MISC[threadIdx.x] = 0u;
    if (bx == 0) { for (int i = threadIdx.x; i < XCD_BAR_WORDS; i += NTHR) __hip_atomic_store(barw + i, 0u, RLX_AGENT); }
    __syncthreads();
    unsigned xid = 0; bool xposted = false;

    for (int ph = lo; ph < hi; ++ph) {
        if (ph > lo) {
            unsigned* bw = (unsigned*)(args.ws + 16384); asm volatile("" : "+s"(bw));
            if (!xposted) { grid.sync(); const XcdBarrier t = xcd_barrier_post(bw, MISC + 8); xid = t.x; xposted = true; }
            else { XcdBarrier t; t.bar = bw; t.x = xid; t.st = MISC + 8; xcd_barrier(t); }
        }
        const int nrep = ((DUP_MASK >> (ph == 0 ? 0 : ((ph - 1) % 13) + 1)) & 1) ? 2 : 1;
        for (int rep = 0; rep < nrep; ++rep) {
        int tid = threadIdx.x; asm volatile("" : "+v"(tid));
        const int lane = tid & 63, wave = __builtin_amdgcn_readfirstlane(tid >> 6);
        const int gw = bx * NWAVES + wave, NGW = G * NWAVES;
        unsigned char* ws = args.ws; asm volatile("" : "+s"(ws));
        float* out = args.out; asm volatile("" : "+s"(out));
        PG8_LAS unsigned char* ldsl = (PG8_LAS unsigned char*)lds;
        float* X = (float*)(ws + WS_X); bf16* Xb = (bf16*)(ws + WS_XB); float* PRE = (float*)(ws + WS_PRE); bf16* P = (bf16*)(ws + WS_P);
        const int l = ph == 0 ? 0 : (ph - 1) / 13; const int k = ph == 0 ? -1 : (ph - 1) % 13;
        unsigned char* wb = ws + (l ? W1OFF : 0);
        if (ph == 0) {
            LayerW L{IN(9), IN(25), IN(28), IN(29), IN(30), IN(31), IN(34), IN(35), IN(36), IN(12), IN(14), IN(15)};
            if (G == 256) { for (int i2 = gw; i2 < CONV_NIT - 2816; i2 += NGW) convert_item(L, ws, (float*)lds + wave * 4160, i2 < 9376 ? i2 : i2 + 2816, lane); }
            else convert_weights(L, ws, (float*)lds + wave * 4160, gw, NGW, lane);
            for (int m = gw; m < MROWS; m += NGW) row_copy_cvt(m < NPR ? IN(0) + (size_t)m * DM : IN(2) + (size_t)(m - NPR) * DM, nullptr, Xb + (size_t)m * DM, lane);
            for (int m = gw; m < 1024; m += NGW) row_copy_cvt(IN(1) + (size_t)m * DM, nullptr, (bf16*)(ws + WS_MEMB) + (size_t)m * DM, lane);
            continue;
        }
        if (k == 6 && l == 0 && G == 256 && (bx >= 68 && (bx < 128 || bx >= 144))) {
            const int idx = bx < 128 ? bx - 68 : bx - 144 + 60;
            LayerW L{IN(9), IN(25), IN(28), IN(29), IN(30), IN(31), IN(34), IN(35), IN(36), IN(12), IN(14), IN(15)};
            for (int i2 = idx * NWAVES + wave; i2 < 2816; i2 += 172 * NWAVES) convert_item(L, ws, (float*)lds + wave * 4160, 9376 + i2, lane);
            continue;
        }
        if (k == 0 || k == 4 || k == 6 || k == 8 || k == 10 || k == 11) {
            const int nsub = (k == 0 || k == 10) ? 1 : 2;
            for (int sub = 0; sub < nsub; ++sub) {
                pg8::Gemm g; pg8::EpiGen E; int cshift = 0;
                E.mode = 0; E.O = PRE; E.ldc = DM; E.res = X; E.alpha = ALPHA; E.split_cols = 0; E.split_stride = 0; E.H = (bf16*)(ws + WS_H); E.ldh = FF; E.nkt = 0; E.kplane = 0;
                g.A = Xb; g.M = MROWS; g.N = DM; g.K = DM; g.Bt = (const bf16*)(wb + WS_WOUT);
                if (k == 0) { g.Bt = (const bf16*)(wb + WS_WIN); g.N = PLD; E.mode = 3; E.H = P; E.ldh = PLD; E.res = nullptr; }
                else if (k == 4) { g.A = (const bf16*)(ws + WS_MIX); if (l == 0) E.res = IN(0); }
                else if (k == 6 && sub == 0) { g.Bt = (const bf16*)(wb + WS_WQ); g.N = XAW; E.O = (float*)(ws + WS_Q); E.ldc = XAW; E.res = nullptr; }
                else if (k == 6) { g.A = (const bf16*)(ws + WS_MEMB); g.Bt = (const bf16*)(wb + WS_WKV); g.M = 1024; g.N = 1024; cshift = 128;
                    E.O = out + O_PMK + (size_t)l * 4 * 256 * 512; E.ldc = 512; E.res = nullptr; E.split_cols = 512; E.split_stride = (size_t)(O_PMV - O_PMK); }
                else if (k == 8) { g.A = (const bf16*)(ws + WS_AO); g.Bt = (const bf16*)(wb + WS_WO); g.K = XAW; }
                else if (k == 10) { g.Bt = (const bf16*)(wb + WS_WGU); g.N = 2 * FF; E.mode = 1; }
                else { g.A = (const bf16*)(ws + WS_H); g.Bt = (const bf16*)(wb + WS_WD); g.K = FF; }
                int nsplit = 1;
                if ((k == 4 || k == 8 || k == 11) && sub == 0) { g.M = NPR; E.mode = 4; E.H = (bf16*)PRE; E.ldh = DM; }
                if ((k == 4 || k == 8 || k == 11) && sub == 1) {
                    g.A += (size_t)NPR * g.K; g.M = NSM; nsplit = (k == 4) ? 8 : (k == 8) ? 4 : 11;
                    E.O = (float*)(ws + WS_PART); E.res = (k == 4 && l == 0) ? IN(2) : X + (size_t)NPR * DM; E.nkt = g.K / 64 / nsplit; E.kplane = (size_t)NSM * DM; }
                g.nt = g.K / 64 / nsplit;
                pg8::StaticOrder S; S.init(g.M, g.N, G, (bx + cshift) % G); S.nsplit = nsplit; S.nkt = g.nt;
                pg8::gemm_phase<pg8::EpiGen, pg8::StaticOrder, true, true>(ldsl, g, S, E);
                __syncthreads();
            }
            continue;
        }
        switch (k) {
        case 1: {
            PrepArgs a;
            a.P = P; a.state_shift = IN(4) + (size_t)l * 128 * RWC; a.state_conv = IN(6) + (size_t)l * 128 * 3 * 3072;
            a.mu = IN(10) + l * RWC; a.w0 = IN(11) + l * 1024; a.a0 = IN(13) + l * 1024; a.kkw = IN(16) + l * 1024; a.kaw = IN(17) + l * 1024;
            a.convw = IN(21) + l * 4 * 3072; a.alog = IN(22) + l * 8; a.dtb = IN(23) + l * 8;
            a.W2t = (const bf16*)(wb + WS_LORA); a.A2t = a.W2t + 65536; a.G2t = a.W2t + 131072;
            a.R = (float*)(ws + WS_R); a.W = (float*)(ws + WS_W); a.K = (float*)(ws + WS_K); a.V = (float*)(ws + WS_V); a.A = (float*)(ws + WS_A); a.B = (float*)(ws + WS_B); a.G = (float*)(ws + WS_G);
            a.QG = (float*)(ws + WS_QG); a.KG = (float*)(ws + WS_KG); a.VG = (float*)(ws + WS_VG); a.BETA = (float*)(ws + WS_BG); a.GDEC = a.BETA + MROWS * 8;
            a.o_psh = out + O_PSH + (size_t)l * 4 * RWC; a.o_pcv = out + O_PCV + (size_t)l * 4 * 3 * 3072; a.o_ssh = out + O_SSH + (size_t)l * 128 * RWC; a.o_scv = out + O_SCV + (size_t)l * 128 * 3 * 3072;
            const int vcu1 = (G % 8 == 0) ? (bx % 8) * (G / 8) + bx / 8 : bx;
            for (int u = vcu1; u < (MROWS / 32) * 4; u += G) prep_rw_unit(a, ldsl, u, tid, wave, lane);
            for (int q = gw; q < MROWS * 4; q += NGW) prep_gd_pair(a, q, lane);
            for (int u = gw; u < 528; u += NGW) prep_copy_unit(a, u, lane);
        } break;
        case 2: {
            ScanArgs a;
            a.R = (const float*)(ws + WS_R); a.W = (const float*)(ws + WS_W); a.K = (const float*)(ws + WS_K); a.V = (const float*)(ws + WS_V); a.A = (const float*)(ws + WS_A); a.B = (const float*)(ws + WS_B);
            a.QG = (const float*)(ws + WS_QG); a.KG = (const float*)(ws + WS_KG); a.VG = (const float*)(ws + WS_VG); a.BETA = (const float*)(ws + WS_BG); a.GDEC = a.BETA + MROWS * 8;
            a.st_rw = IN(3) + (size_t)l * 128 * 16 * 4096; a.st_gd = IN(5) + (size_t)l * 128 * 8 * 16384;
            a.ORW = (float*)(ws + WS_ORW); a.OGD = (float*)(ws + WS_OGD);
            a.o_prw = out + O_PRW + (size_t)l * 4 * 16 * 4096; a.o_pgd = out + O_PGD + (size_t)l * 4 * 8 * 16384;
            a.o_srw = out + O_SRW + (size_t)l * 128 * 16 * 4096; a.o_sgd = out + O_SGD + (size_t)l * 128 * 8 * 16384;
            const int vcu = (G % 8 == 0) ? (bx % 8) * (G / 8) + bx / 8 : bx;
            if (G == 256) {
                scan_prompt(a, ldsl, vcu, tid, wave, lane, vcu * 4 + (wave & 3), l == 0, args, ws + W1OFF);
            } else {
                for (int it = vcu; it < 256; it += G) scan_prompt(a, ldsl, it, tid, wave, lane, 0, false, args, nullptr);
                for (int srep = 0; srep < SAMPLE_REPS; ++srep)
                for (int u = vcu * NWAVES + wave; u < 32768; u += NGW) { if (u < 16384) scan_sample_rw<2>(a, u, lane); else scan_sample_gd<2>(a, u - 16384, lane); }
            }
        } break;
        case 3: {
            PostArgs a;
            a.P = P; a.R = (const float*)(ws + WS_R); a.K = (const float*)(ws + WS_K); a.V = (const float*)(ws + WS_V); a.G = (const float*)(ws + WS_G);
            a.ORW = (const float*)(ws + WS_ORW); a.OGD = (const float*)(ws + WS_OGD);
            a.rk = IN(18) + l * 1024; a.lnxw = IN(19) + l * 1024; a.lnxb = IN(20) + l * 1024; a.normw = IN(24) + l * 128; a.MIX = (bf16*)(ws + WS_MIX);
            for (int m = gw; m < MROWS; m += NGW) post_row(a, m, lane);
        } break;
        case 5: case 9: case 12: {
            const int gi = k == 5 ? 26 : k == 9 ? 32 : 37;
            const float* gg = IN(gi) + l * DM; const float* bb = IN(gi + 1) + l * DM;
            const bool fin = (k == 12 && l == 1);
            for (int m = gw; m < MROWS; m += NGW) {
                float* df = fin ? (m < NPR ? out + O_YP + (size_t)m * DM : out + O_YS + (size_t)(m - NPR) * DM) : X + (size_t)m * DM;
                const bool smp = m >= NPR;
                ln_row((const float*)(ws + WS_PART) + (size_t)(smp ? m - NPR : 0) * DM, smp ? nullptr : (const bf16*)PRE + (size_t)m * DM, smp ? (k == 5 ? 8 : k == 9 ? 4 : 11) : 1, gg, bb, df, fin ? nullptr : Xb + (size_t)m * DM, lane);
            }
            if (k == 12 && l == 0 && G != 256) {
                LayerW L{IN(9) + (size_t)DM * INC, IN(25) + (size_t)DM * DM, IN(28) + (size_t)DM * XAW, IN(29) + (size_t)DM * XAW, IN(30) + (size_t)DM * XAW,
                         IN(31) + (size_t)XAW * DM, IN(34) + (size_t)DM * FF, IN(35) + (size_t)DM * FF, IN(36) + (size_t)FF * DM,
                         IN(12) + 65536, IN(14) + 65536, IN(15) + 131072};
                convert_weights(L, ws + W1OFF, (float*)lds + wave * 4160, gw, NGW, lane);
            }
        } break;
        case 7: {
            const float* Q = (const float*)(ws + WS_Q); bf16* AO = (bf16*)(ws + WS_AO);
            const int vcu7 = (G % 8 == 0) ? (bx % 8) * (G / 8) + bx / 8 : bx;
            for (int u = vcu7; u < 256 + 512; u += G) {
                if (u < 256) { const int b = u >> 6, h = (u >> 4) & 3, qb = u & 15;
                    const size_t kvo = ((size_t)(l * 4 + b) * 256) * 512 + h * 128;
                    attn_unit(out + O_PMK + kvo, out + O_PMV + kvo, Q, AO, b * SEQ + qb * 128, 128, true, h * 128, lds, tid, wave, lane);
                } else { const int j = u - 256; const int b = j >> 2, h = j & 3;
                    const size_t kvo = ((size_t)(l * 128 + b) * 256) * 512 + h * 128;
                    attn_unit(IN(7) + kvo, IN(8) + kvo, Q, AO, NPR + b * 4, 4, false, h * 128, lds, tid, wave, lane);
                }
            }
        } break;
        default: break;
        }
        }
    }
}

#ifndef MK_PER_PHASE
#define MK_PER_PHASE 0
#endif
extern "C" void kernel_launch(void* const* d_in, const int* in_sizes, int n_in, void* d_out, int out_size, void* d_ws, size_t ws_size, hipStream_t stream) {
    static int grid = 0;
    if (grid == 0) {
        if (n_in != 39 || (size_t)out_size != O_END || ws_size < WS_END) { fprintf(stderr, "kernel_launch: unexpected sizes n_in %d out %d ws %zu (need %zu)\n", n_in, out_size, ws_size, (size_t)WS_END); }
        int dev = 0, cus = 0, per_cu = 0;
        hipGetDevice(&dev); hipDeviceGetAttribute(&cus, hipDeviceAttributeMultiprocessorCount, dev);
        hipFuncSetAttribute((const void*)fwd_megakernel, hipFuncAttributeMaxDynamicSharedMemorySize, LDS_BYTES);
        hipOccupancyMaxActiveBlocksPerMultiprocessor(&per_cu, (const void*)fwd_megakernel, NTHR, LDS_BYTES);
        if (per_cu < 1) { fprintf(stderr, "kernel_launch: occupancy query says %d\n", per_cu); per_cu = 1; }
        grid = cus * 1;
        if (cus <= 0) grid = 256;
    }
    Args a{};
    for (int i = 0; i < 39; ++i) a.in[i] = (const float*)d_in[i];
    a.out = (float*)d_out; a.ws = (unsigned char*)d_ws;
#if MK_PER_PHASE
    for (int p = 0; p < NPHASE; ++p) { a.ph_lo = p; a.ph_hi = p + 1; void* kargs[] = {&a};
        hipError_t e = hipLaunchCooperativeKernel((const void*)fwd_megakernel, dim3(grid), dim3(NTHR), kargs, LDS_BYTES, stream);
        if (e != hipSuccess) { fprintf(stderr, "launch %d failed: %s\n", p, hipGetErrorString(e)); break; } }
#else
    a.ph_lo = 0; a.ph_hi = NPHASE; void* kargs[] = {&a};
    hipError_t e = hipLaunchCooperativeKernel((const void*)fwd_megakernel, dim3(grid), dim3(NTHR), kargs, LDS_BYTES, stream);
    if (e != hipSuccess) fprintf(stderr, "cooperative launch failed: %s (grid %d)\n", hipGetErrorString(e), grid);
#endif
}
```

```cpp
#include <hip/hip_runtime.h>
#include <hip/hip_cooperative_groups.h>
#include <cstdio>
#include <cstdint>
namespace cg = cooperative_groups;
#define DUP_MASK 0
#define SAMPLE_REPS 1
namespace pg8 {
#define PG8_LAS __attribute__((address_space(3)))
typedef unsigned short bf16_t;
typedef short bf16x8 __attribute__((ext_vector_type(8)));
typedef float f32x4 __attribute__((ext_vector_type(4)));
typedef unsigned u32x4 __attribute__((ext_vector_type(4)));
constexpr int BM = 256, BK = 64, HALF = 128, HTB = HALF * BK * 2  , STAGE_BYTES = 8 * HTB, NXCD = 8, WGM = 8;

__host__ __device__ __forceinline__ int lds_byte(int r, int c) { const int st = (r >> 4) * 2 + (c >> 5), rr = r & 15, cc = c & 31, ob = rr * 64 + cc * 2; return st * 1024 + (ob ^ (((ob >> 9) & 1) << 5)); }
__host__ __device__ __forceinline__ void stage_rc(int b, int& R, int& C) { const int st = b / 1024, sb = b % 1024, swz = sb ^ (((sb >> 9) & 1) << 5); R = (st >> 1) * 16 + swz / 64; C = (st & 1) * 32 + (swz % 64) / 2; }
__host__ __device__ __forceinline__ int perm32(int rho) { const int n = rho >> 4, i = rho & 15; return 8 * (i >> 2) + 4 * n + (i & 3); }

struct Unit { int pm, pn, kt0; };
struct Gemm { const bf16_t* A; const bf16_t* Bt; int M, N, K, nt; };

struct StaticOrder {
    int nM, nN, nwg, G, c, nsplit, nkt;
    __host__ __device__ void init(int M, int N, int G_, int c_) { nM = M / BM; nN = N / BM; nwg = nM * nN; G = G_; c = c_; nsplit = 1; nkt = 0; }
    __host__ __device__ bool next(int i, Unit& u) const {
        const long L0 = (long)i * G + c; const long tot = (long)nwg * nsplit; const bool ok = L0 < tot; const int L = ok ? (int)L0 : 0;
        int pm, pn, kt0;
        if (nsplit > 1) { const int tile = L % nwg, sp = L / nwg; pm = tile / nN; pn = tile % nN; kt0 = sp * nkt; }
        else {
            int wgid = L; { const int q = nwg / NXCD, r = nwg % NXCD, xcd = wgid % NXCD, off = wgid / NXCD; wgid = (xcd < r ? xcd * (q + 1) : r * (q + 1) + (xcd - r) * q) + off; }
            const int nig = WGM * nN, gid = wgid / nig, fm = gid * WGM, gsz = (nM - fm) < WGM ? (nM - fm) : WGM;
            pm = fm + ((wgid % nig) % gsz); pn = (wgid % nig) / gsz; kt0 = 0;
        }
        u.pm = pm; u.pn = pn; u.kt0 = kt0; return ok;
    }
    __device__ __forceinline__ void a_ready(const Unit&) const {}
    __device__ __forceinline__ void done(const Unit&) const {}
};

__device__ __forceinline__ unsigned cvt_pk_bf16(float lo, float hi) { unsigned r; asm volatile("v_cvt_pk_bf16_f32 %0, %1, %2" : "=v"(r) : "v"(lo), "v"(hi)); return r; }
typedef float f32x2 __attribute__((ext_vector_type(2)));

#define PG8_GAS __attribute__((address_space(1)))
struct EpiF32 {
    static constexpr bool PERM = true, AFTER_DRAIN = false;
    float* O; int ldc; const float* res_; float alpha; int split_cols; size_t split_stride; int nkt; size_t kplane;
    __device__ __forceinline__ void operator()(const f32x4 (&acc)[2][2][4][2], const Unit& u, int wr, int wc, int fr, int fq) const {
        const int row0 = u.pm * BM + wr * 64 + fr; int colt = u.pn * BM; float* base = O; const float* res = res_;
        if (nkt) { const int sp = u.kt0 / nkt; base += (size_t)sp * kplane; if (sp) res = nullptr; }
        if (split_cols) { const int t = colt / split_cols; base += (size_t)t * split_stride; colt -= t * split_cols; }
        const int col0 = colt + wc * 32 + 8 * fq;
#pragma unroll
        for (int ai = 0; ai < 2; ++ai)
#pragma unroll
            for (int m = 0; m < 4; ++m) {
                const size_t ro = (size_t)(row0 + ai * HALF + m * 16) * ldc + col0;
#pragma unroll
                for (int bj = 0; bj < 2; ++bj) {
                    f32x4 v0 = acc[ai][bj][m][0], v1 = acc[ai][bj][m][1];
                    if (res) { const f32x4 r0 = *(const PG8_GAS f32x4*)(res + ro + bj * HALF), r1 = *(const PG8_GAS f32x4*)(res + ro + bj * HALF + 4); v0 += r0 * alpha; v1 += r1 * alpha; }
                    *(PG8_GAS f32x4*)(base + ro + bj * HALF) = v0; *(PG8_GAS f32x4*)(base + ro + bj * HALF + 4) = v1;
                }
            }
    }
};
struct EpiSwiGLU {
    static constexpr bool PERM = true, AFTER_DRAIN = false;
    bf16_t* H; int ldh;
    __device__ __forceinline__ void operator()(const f32x4 (&acc)[2][2][4][2], const Unit& u, int wr, int wc, int fr, int fq) const {
        const int row0 = u.pm * BM + wr * 64 + fr; const int hc0 = u.pn * 128 + wc * 16 + 4 * fq;
#pragma unroll
        for (int ai = 0; ai < 2; ++ai)
#pragma unroll
            for (int m = 0; m < 4; ++m) {
                bf16_t* rowp = H + (size_t)(row0 + ai * HALF + m * 16) * ldh + hc0;
#pragma unroll
                for (int bj = 0; bj < 2; ++bj) {
                    const f32x4 g = acc[ai][bj][m][0], up = acc[ai][bj][m][1]; float h[4];
#pragma unroll
                    for (int e = 0; e < 4; ++e) h[e] = g[e] * __builtin_amdgcn_rcpf(1.0f + __expf(-g[e])) * up[e];
                    typedef unsigned u32x2v __attribute__((ext_vector_type(2)));
                    u32x2v w; w.x = cvt_pk_bf16(h[0], h[1]); w.y = cvt_pk_bf16(h[2], h[3]);
                    *(PG8_GAS u32x2v*)(rowp + bj * 64) = w;
                }
            }
    }
};

struct EpiAtomic {
    float* O; int ldc;
    __device__ __forceinline__ void operator()(const f32x4 (&acc)[2][2][4][2], const Unit& u, int wr, int wc, int fr, int fq) const {
        const int row0 = u.pm * BM + wr * 64 + fr; const int col0 = u.pn * BM + wc * 32 + 8 * fq;
#pragma unroll
        for (int ai = 0; ai < 2; ++ai)
#pragma unroll
            for (int m = 0; m < 4; ++m) {
                PG8_GAS float* rp = (PG8_GAS float*)(O + (size_t)(row0 + ai * HALF + m * 16) * ldc + col0);
#pragma unroll
                for (int bj = 0; bj < 2; ++bj)
#pragma unroll
                    for (int n = 0; n < 2; ++n)
#pragma unroll
                        for (int e = 0; e < 4; ++e) __hip_atomic_fetch_add(rp + bj * HALF + 4 * n + e, acc[ai][bj][m][n][e], __ATOMIC_RELAXED, __HIP_MEMORY_SCOPE_AGENT);
            }
    }
};
struct EpiBf16 {
    bf16_t* O; int ld;
    __device__ __forceinline__ void operator()(const f32x4 (&acc)[2][2][4][2], const Unit& u, int wr, int wc, int fr, int fq) const {
        const int row0 = u.pm * BM + wr * 64 + fr; const int col0 = u.pn * BM + wc * 32 + 8 * fq;
#pragma unroll
        for (int ai = 0; ai < 2; ++ai)
#pragma unroll
            for (int m = 0; m < 4; ++m) {
                bf16_t* rowp = O + (size_t)(row0 + ai * HALF + m * 16) * ld + col0;
#pragma unroll
                for (int bj = 0; bj < 2; ++bj) { const f32x4 v0 = acc[ai][bj][m][0], v1 = acc[ai][bj][m][1];
                    u32x4 w; w.x = cvt_pk_bf16(v0[0], v0[1]); w.y = cvt_pk_bf16(v0[2], v0[3]); w.z = cvt_pk_bf16(v1[0], v1[1]); w.w = cvt_pk_bf16(v1[2], v1[3]);
                    *(PG8_GAS u32x4*)(rowp + bj * HALF) = w; }
            }
    }
};
struct EpiBf16Res {
    bf16_t* O; int ld; const float* res; float alpha;
    __device__ __forceinline__ void operator()(const f32x4 (&acc)[2][2][4][2], const Unit& u, int wr, int wc, int fr, int fq) const {
        const int row0 = u.pm * BM + wr * 64 + fr; const int col0 = u.pn * BM + wc * 32 + 8 * fq;
#pragma unroll
        for (int ai = 0; ai < 2; ++ai)
#pragma unroll
            for (int m = 0; m < 4; ++m) {
                const size_t ro = (size_t)(row0 + ai * HALF + m * 16) * ld + col0;
#pragma unroll
                for (int bj = 0; bj < 2; ++bj) {
                    const f32x4 r0 = *(const PG8_GAS f32x4*)(res + ro + bj * HALF), r1 = *(const PG8_GAS f32x4*)(res + ro + bj * HALF + 4);
                    const f32x4 v0 = acc[ai][bj][m][0] + r0 * alpha, v1 = acc[ai][bj][m][1] + r1 * alpha;
                    u32x4 w; w.x = cvt_pk_bf16(v0[0], v0[1]); w.y = cvt_pk_bf16(v0[2], v0[3]); w.z = cvt_pk_bf16(v1[0], v1[1]); w.w = cvt_pk_bf16(v1[2], v1[3]);
                    *(PG8_GAS u32x4*)(O + ro + bj * HALF) = w; }
            }
    }
};
struct EpiGen {
    static constexpr bool PERM = true, AFTER_DRAIN = false;
    int mode; float* O; int ldc; const float* res; float alpha; int split_cols; size_t split_stride; bf16_t* H; int ldh; int nkt; size_t kplane;
    __device__ __forceinline__ void operator()(const f32x4 (&acc)[2][2][4][2], const Unit& u, int wr, int wc, int fr, int fq) const {
        if (mode == 0) { EpiF32 e{O, ldc, res, alpha, split_cols, split_stride, nkt, kplane}; e(acc, u, wr, wc, fr, fq); }
        else if (mode == 1) { EpiSwiGLU e{H, ldh}; e(acc, u, wr, wc, fr, fq); }
        else if (mode == 3) { EpiBf16 e{H, ldh}; e(acc, u, wr, wc, fr, fq); }
        else if (mode == 4) { EpiBf16Res e{H, ldh, res, alpha}; e(acc, u, wr, wc, fr, fq); }
        else { EpiAtomic e{O, ldc}; e(acc, u, wr, wc, fr, fq); }
    }
};
template <class Epi, class Sched, bool ALIGN_EPI = false, bool SP2 = false>
__device__ __forceinline__ void gemm_phase(PG8_LAS unsigned char* lds, const Gemm g, const Sched& S, const Epi& E) {
    int tid_ = threadIdx.x; asm volatile("" : "+v"(tid_));
    const int tid = tid_, wid = __builtin_amdgcn_readfirstlane(tid >> 6), lane = tid & 63, wr = wid >> 2, wc = wid & 3, fr = lane & 15, fq = lane >> 4;
    const int K = g.K, nt = g.nt;
    unsigned voffA[2], voffB[2];
#pragma unroll
    for (int i = 0; i < 2; ++i) { int R, C; stage_rc(tid * 16 + i * 8192, R, C); const int Rb = Epi::PERM ? ((R & ~31) + perm32(R & 31)) : R;
        voffA[i] = (unsigned)(R * K + C) * 2u; voffB[i] = (unsigned)(Rb * K + C) * 2u; }
    const size_t kstep = (size_t)(BK * 2);
    const size_t hstep = (size_t)HALF * K * 2;
    const size_t tstep = 2 * hstep;
    const unsigned ldsw = (unsigned)wid * 1024u;
    const int aoff = lds_byte(wr * 64 + fr, fq * 8), boff = lds_byte(wc * 32 + fr, fq * 8);
#define PG8_SA(b, h) (((b) * 2 + (h)) * HTB)
#define PG8_SB(b, h) ((4 + (b) * 2 + (h)) * HTB)
#define PG8_STAGE(bufoff, gbase, voff) do { _Pragma("unroll") for (int _i = 0; _i < 2; ++_i) \
        __builtin_amdgcn_global_load_lds((const unsigned*)((const char*)(gbase) + (voff)[_i]), (PG8_LAS unsigned*)(lds + (bufoff) + ldsw + _i * 8192), 16, 0, 0); } while (0)
#define PG8_LDA(dst, b, h) do { _Pragma("unroll") for (int m = 0; m < 4; ++m) _Pragma("unroll") for (int k = 0; k < 2; ++k) dst[m][k] = *(const PG8_LAS bf16x8*)(lds + PG8_SA(b, h) + aoff + m * 2048 + k * 1024); } while (0)
#define PG8_LDB(dst, b, h) do { _Pragma("unroll") for (int n = 0; n < 2; ++n) _Pragma("unroll") for (int k = 0; k < 2; ++k) dst[n][k] = *(const PG8_LAS bf16x8*)(lds + PG8_SB(b, h) + boff + n * 2048 + k * 1024); } while (0)
#define PG8_MMA(ai, bj, At, Bt) do { __builtin_amdgcn_s_setprio(1); _Pragma("unroll") for (int m = 0; m < 4; ++m) _Pragma("unroll") for (int n = 0; n < 2; ++n) _Pragma("unroll") for (int k = 0; k < 2; ++k) \
        acc[ai][bj][m][n] = __builtin_amdgcn_mfma_f32_16x16x32_bf16(Bt[n][k], At[m][k], acc[ai][bj][m][n], 0, 0, 0); __builtin_amdgcn_s_setprio(0); } while (0)
#define PG8_WAIT_V(n) asm volatile("s_waitcnt vmcnt(" #n ")" ::: "memory")
#define PG8_WAIT_L(n) asm volatile("s_waitcnt lgkmcnt(" #n ")" ::: "memory")
#define PG8_BAR __builtin_amdgcn_s_barrier()
#define PG8_SCHED __builtin_amdgcn_sched_barrier(0)
    Unit cur, nxt; int ui = 0;
    if (!S.next(0, cur)) return;
    f32x4 acc[2][2][4][2];
#pragma unroll
    for (int a = 0; a < 2; ++a)
#pragma unroll
        for (int b = 0; b < 2; ++b)
#pragma unroll
            for (int m = 0; m < 4; ++m)
#pragma unroll
                for (int n = 0; n < 2; ++n) acc[a][b][m][n] = (f32x4){0.f, 0.f, 0.f, 0.f};
    bf16x8 At[4][2], B0[2][2], B1[2][2];
    const char* cA = (const char*)g.A + (size_t)cur.pm * tstep + (size_t)cur.kt0 * kstep; const char* cB = (const char*)g.Bt + (size_t)cur.pn * tstep + (size_t)cur.kt0 * kstep;
    S.a_ready(cur);
    if constexpr (SP2) {
        PG8_STAGE(PG8_SB(0, 0), cB, voffB); PG8_STAGE(PG8_SB(0, 1), cB + hstep, voffB); PG8_STAGE(PG8_SA(0, 0), cA, voffA); PG8_STAGE(PG8_SA(0, 1), cA + hstep, voffA);
        if (wr == 1) PG8_BAR;
        PG8_WAIT_V(2); PG8_BAR;
        PG8_STAGE(PG8_SB(1, 0), cB + kstep, voffB); PG8_STAGE(PG8_SA(1, 0), cA + kstep, voffA); PG8_STAGE(PG8_SB(1, 1), cB + hstep + kstep, voffB);
        PG8_WAIT_V(6); PG8_BAR;
    } else {
        PG8_STAGE(PG8_SB(0, 0), cB, voffB); PG8_STAGE(PG8_SA(0, 0), cA, voffA); PG8_STAGE(PG8_SB(0, 1), cB + hstep, voffB); PG8_STAGE(PG8_SA(0, 1), cA + hstep, voffA);
        if (wr == 1) PG8_BAR;
        PG8_WAIT_V(4); PG8_BAR;
        PG8_STAGE(PG8_SB(1, 0), cB + kstep, voffB); PG8_STAGE(PG8_SA(1, 0), cA + kstep, voffA); PG8_STAGE(PG8_SB(1, 1), cB + hstep + kstep, voffB);
        PG8_WAIT_V(6); PG8_BAR;
    }
    for (;;) {
        const bool has_next = S.next(ui + 1, nxt);
        const char* nA = has_next ? (const char*)g.A + (size_t)nxt.pm * tstep + (size_t)nxt.kt0 * kstep : cA; const char* nB = has_next ? (const char*)g.Bt + (size_t)nxt.pn * tstep + (size_t)nxt.kt0 * kstep : cB;
        for (int t = 0; t < nt; t += 2) {
            const bool last = (t == nt - 2);
            const char* a1 = cA + (size_t)(t + 1) * kstep;
            const char* a2 = last ? nA : cA + (size_t)(t + 2) * kstep; const char* b2 = last ? nB : cB + (size_t)(t + 2) * kstep;
            const char* a3 = a2 + kstep; const char* b3 = b2 + kstep;
            if (last && has_next) S.a_ready(nxt);
            if constexpr (SP2) {
            PG8_LDB(B0, 0, 0); PG8_LDB(B1, 0, 1); PG8_SCHED; PG8_LDA(At, 0, 0); PG8_STAGE(PG8_SA(1, 1), a1 + hstep, voffA);
            PG8_WAIT_V(8); PG8_WAIT_L(0); PG8_BAR; PG8_MMA(0, 0, At, B0); PG8_MMA(0, 1, At, B1); PG8_BAR; PG8_SCHED;
            PG8_LDA(At, 0, 1); PG8_STAGE(PG8_SB(0, 0), b2, voffB); PG8_STAGE(PG8_SB(0, 1), b2 + hstep, voffB); PG8_STAGE(PG8_SA(0, 0), a2, voffA);
            PG8_WAIT_V(8); PG8_WAIT_L(0); PG8_BAR; PG8_MMA(1, 0, At, B0); PG8_MMA(1, 1, At, B1); PG8_BAR; PG8_SCHED;
            PG8_LDB(B0, 1, 0); PG8_LDB(B1, 1, 1); PG8_SCHED; PG8_LDA(At, 1, 0); PG8_STAGE(PG8_SA(0, 1), a2 + hstep, voffA);
            PG8_WAIT_V(8); PG8_WAIT_L(0); PG8_BAR; PG8_MMA(0, 0, At, B0); PG8_MMA(0, 1, At, B1); PG8_BAR; PG8_SCHED;
            PG8_LDA(At, 1, 1); PG8_STAGE(PG8_SB(1, 0), b3, voffB); PG8_STAGE(PG8_SB(1, 1), b3 + hstep, voffB); PG8_STAGE(PG8_SA(1, 0), a3, voffA);
            PG8_WAIT_V(8); PG8_WAIT_L(0); PG8_BAR; PG8_MMA(1, 0, At, B0); PG8_MMA(1, 1, At, B1); PG8_BAR; PG8_SCHED;
            } else {
            PG8_LDB(B0, 0, 0); PG8_SCHED; PG8_LDA(At, 0, 0); PG8_STAGE(PG8_SA(1, 1), a1 + hstep, voffA);
            PG8_WAIT_L(8); PG8_BAR; PG8_WAIT_L(0); PG8_MMA(0, 0, At, B0); PG8_BAR; PG8_SCHED;
            PG8_LDB(B1, 0, 1); PG8_STAGE(PG8_SB(0, 0), b2, voffB);
            PG8_BAR; PG8_WAIT_L(0); PG8_MMA(0, 1, At, B1); PG8_BAR;
            PG8_LDA(At, 0, 1); PG8_STAGE(PG8_SA(0, 0), a2, voffA);
            PG8_BAR; PG8_WAIT_L(0); PG8_MMA(1, 0, At, B0); PG8_BAR; PG8_SCHED;
            PG8_STAGE(PG8_SB(0, 1), b2 + hstep, voffB);
            PG8_WAIT_V(6); PG8_BAR; PG8_MMA(1, 1, At, B1); PG8_BAR;
            PG8_LDB(B0, 1, 0); PG8_SCHED; PG8_LDA(At, 1, 0); PG8_STAGE(PG8_SA(0, 1), a2 + hstep, voffA);
            PG8_WAIT_L(8); PG8_BAR; PG8_WAIT_L(0); PG8_MMA(0, 0, At, B0); PG8_BAR; PG8_SCHED;
            PG8_LDB(B1, 1, 1); PG8_STAGE(PG8_SB(1, 0), b3, voffB);
            PG8_BAR; PG8_WAIT_L(0); PG8_MMA(0, 1, At, B1); PG8_BAR;
            PG8_LDA(At, 1, 1); PG8_STAGE(PG8_SA(1, 0), a3, voffA);
            PG8_BAR; PG8_WAIT_L(0); PG8_MMA(1, 0, At, B0); PG8_BAR; PG8_SCHED;
            PG8_STAGE(PG8_SB(1, 1), b3 + hstep, voffB);
            PG8_WAIT_V(6); PG8_BAR; PG8_MMA(1, 1, At, B1); PG8_BAR;
            }
        }
        if constexpr (ALIGN_EPI) { if (wr == 0) PG8_BAR; }
        if constexpr (!Epi::AFTER_DRAIN) { E(acc, cur, wr, wc, fr, fq); S.done(cur); }
        if (!has_next) break;
#pragma unroll
        for (int a = 0; a < 2; ++a)
#pragma unroll
            for (int b = 0; b < 2; ++b)
#pragma unroll
                for (int m = 0; m < 4; ++m)
#pragma unroll
                    for (int n = 0; n < 2; ++n) acc[a][b][m][n] = (f32x4){0.f, 0.f, 0.f, 0.f};
        cur = nxt; cA = nA; cB = nB; ++ui;
        if constexpr (ALIGN_EPI) { if (wr == 1) PG8_BAR; }
    }
    PG8_WAIT_V(0);
    if constexpr (!ALIGN_EPI) { if (wr == 0) PG8_BAR; }
    PG8_BAR;
    if constexpr (Epi::AFTER_DRAIN) { E.fused(acc, cur, wr, wc, fr, fq, lds, wid, lane); S.done(cur); }
#undef PG8_SA
#undef PG8_SB
#undef PG8_STAGE
#undef PG8_LDA
#undef PG8_LDB
#undef PG8_MMA
#undef PG8_WAIT_V
#undef PG8_WAIT_L
#undef PG8_BAR
#undef PG8_SCHED
}
}

typedef unsigned short bf16;
typedef float f32x4 __attribute__((ext_vector_type(4)));
typedef float f32x2 __attribute__((ext_vector_type(2)));
typedef short bf16x8 __attribute__((ext_vector_type(8)));
typedef unsigned u32x4 __attribute__((ext_vector_type(4)));
typedef unsigned u32x2 __attribute__((ext_vector_type(2)));

constexpr int NWAVES = 8, NTHR = 512;
constexpr int DM = 2048, NPR = 8192, NSM = 512, MROWS = 8704, SEQ = 2048;
constexpr int RWC = 3328, INC = 7440, PLD = 7680, GD0 = 3328;
constexpr int FF = 5632, XAW = 512;
constexpr float ALPHA = 1.41421356237f;
constexpr int LDS_BYTES = 147456;

constexpr size_t O_YP = 0, O_YS = O_YP + (size_t)NPR * DM, O_PRW = O_YS + (size_t)NSM * DM, O_PSH = O_PRW + 2ull * 4 * 16 * 4096,
    O_PGD = O_PSH + 2ull * 4 * RWC, O_PCV = O_PGD + 2ull * 4 * 8 * 16384, O_PMK = O_PCV + 2ull * 4 * 3 * 3072, O_PMV = O_PMK + 2ull * 4 * 256 * 512,
    O_SRW = O_PMV + 2ull * 4 * 256 * 512, O_SSH = O_SRW + 2ull * 128 * 16 * 4096, O_SGD = O_SSH + 2ull * 128 * RWC, O_SCV = O_SGD + 2ull * 128 * 8 * 16384,
    O_END = O_SCV + 2ull * 128 * 3 * 3072;
static_assert(O_END == 75139072ull, "output size");

constexpr size_t MiB = 1u << 20;
constexpr size_t WS_WIN = 1 * MiB, WS_WOUT = WS_WIN + 30 * MiB, WS_WQ = WS_WOUT + 8 * MiB, WS_WKV = WS_WQ + 2 * MiB, WS_WO = WS_WKV + 4 * MiB,
    WS_WGU = WS_WO + 2 * MiB, WS_WD = WS_WGU + 44 * MiB, WS_LORA = WS_WD + 22 * MiB, WS_X = WS_LORA + 1 * MiB, WS_XB = WS_X + 68 * MiB, WS_MEMB = WS_XB + 34 * MiB,
    WS_P = WS_MEMB + 4 * MiB, WS_SC = WS_P + 255 * MiB, WS_END = WS_SC + 442 * MiB;
constexpr size_t WS_PRE = WS_P;
constexpr size_t W1OFF = WS_P + 128 * MiB - WS_WIN;
static_assert(W1OFF + WS_X <= WS_SC, "second weight set inside the P region");
constexpr size_t SCB = 34 * MiB;
constexpr unsigned SCBF = (unsigned)(SCB / 4);
constexpr size_t WS_R = WS_SC, WS_W = WS_R + SCB, WS_K = WS_W + SCB, WS_V = WS_K + SCB, WS_A = WS_V + SCB, WS_B = WS_A + SCB, WS_G = WS_B + SCB,
    WS_QG = WS_G + SCB, WS_KG = WS_QG + SCB, WS_VG = WS_KG + SCB, WS_BG = WS_VG + SCB, WS_ORW = WS_BG + SCB, WS_OGD = WS_ORW + SCB;
static_assert(WS_OGD + SCB <= WS_END, "scan region");
constexpr size_t WS_MIX = WS_W;
constexpr size_t WS_H = WS_A, WS_Q = WS_QG, WS_AO = WS_KG, WS_PART = WS_VG;
static_assert(94 * MiB <= 3 * SCB && 44 * MiB <= 2 * SCB, "overlays");

__device__ __forceinline__ unsigned f2bf(float f) { unsigned u = __builtin_bit_cast(unsigned, f); return (u + 0x7fffu + ((u >> 16) & 1u)) >> 16; }
__device__ __forceinline__ unsigned pk2(float lo, float hi) { return f2bf(lo) | (f2bf(hi) << 16); }
template <int CTRL> __device__ __forceinline__ float dppf(float x) { return __builtin_bit_cast(float, __builtin_amdgcn_mov_dpp(__builtin_bit_cast(int, x), CTRL, 0xf, 0xf, true)); }
__device__ __forceinline__ float reduce16(float v) {
    v += dppf<0xB1>(v); v += dppf<0x4E>(v); v += dppf<0x141>(v); v += dppf<0x128>(v); return v;
}
__device__ __forceinline__ float reduce8(float v) {
    v += dppf<0xB1>(v); v += dppf<0x4E>(v); v += dppf<0x141>(v); return v;
}
__device__ __forceinline__ float wave_sum(float v) {
    v = reduce16(v); const int iv = __builtin_bit_cast(int, v);
    return (__builtin_bit_cast(float, __builtin_amdgcn_readlane(iv, 0)) + __builtin_bit_cast(float, __builtin_amdgcn_readlane(iv, 16))) +
           (__builtin_bit_cast(float, __builtin_amdgcn_readlane(iv, 32)) + __builtin_bit_cast(float, __builtin_amdgcn_readlane(iv, 48)));
}
#define GAS __attribute__((address_space(1)))
#define LAS __attribute__((address_space(3)))
__device__ __forceinline__ f32x4 ldg4(const float* p) { return *(const GAS f32x4*)p; }
__device__ __forceinline__ float ldg1(const float* p) { return *(const GAS float*)p; }
__device__ __forceinline__ void stg4(float* p, f32x4 v) { *(GAS f32x4*)p = v; }
__device__ __forceinline__ void stg1(float* p, float v) { *(GAS float*)p = v; }
__device__ __forceinline__ void stgb(bf16* p, unsigned v) { *(GAS bf16*)p = (bf16)v; }
__device__ __forceinline__ f32x2 lo2(f32x4 a) { return (f32x2){a.x, a.y}; }
__device__ __forceinline__ f32x2 hi2(f32x4 a) { return (f32x2){a.z, a.w}; }
__device__ __forceinline__ f32x4 ldb4(const bf16* p) { const u32x2 w = *(const GAS u32x2*)p;
    return (f32x4){__builtin_bit_cast(float, w.x << 16), __builtin_bit_cast(float, w.x & 0xffff0000u), __builtin_bit_cast(float, w.y << 16), __builtin_bit_cast(float, w.y & 0xffff0000u)}; }
__device__ __forceinline__ float ldb1(const bf16* p) { return __builtin_bit_cast(float, (unsigned)(*(const GAS bf16*)p) << 16); }
__device__ __forceinline__ float dot4(f32x4 a, f32x4 b) { f32x2 p = lo2(a) * lo2(b); p = __builtin_elementwise_fma(hi2(a), hi2(b), p); return p.x + p.y; }
__device__ __forceinline__ float dot8(f32x4 a0, f32x4 a1, f32x4 b0, f32x4 b1) {
    f32x2 p = lo2(a0) * lo2(b0), q = hi2(a0) * hi2(b0); p = __builtin_elementwise_fma(lo2(a1), lo2(b1), p); q = __builtin_elementwise_fma(hi2(a1), hi2(b1), q); p = p + q; return p.x + p.y; }
__device__ __forceinline__ float rcpf_(float x) { return __builtin_amdgcn_rcpf(x); }
__device__ __forceinline__ float rsqf_(float x) { return __builtin_amdgcn_rsqf(x); }
__device__ __forceinline__ float sigmoidf_(float x) { return rcpf_(1.0f + __expf(-x)); }
__device__ __forceinline__ float softplusf_(float x) { return fmaxf(x, 0.f) + __logf(1.0f + __expf(-fabsf(x))); }
__device__ __forceinline__ float tanhf_(float x) { return 1.0f - 2.0f * rcpf_(1.0f + __expf(2.0f * x)); }
#define LDS_WAIT() asm volatile("s_waitcnt lgkmcnt(0)" ::: "memory")

__device__ __forceinline__ void tr_item(const float* __restrict__ W, int K, int N, bf16* __restrict__ WT, int mode, int row_off, float* scr, int item, int lane) {
    const int nblk = (N + 63) >> 6; const int kb = item / nblk, nb = item - kb * nblk; const int k0 = kb * 64, n0 = nb * 64;
    const int kr = lane >> 4, nc = (lane & 15) * 4; const bool nv = n0 + nc < N;
    f32x4 v[16];
#pragma unroll
    for (int j = 0; j < 16; ++j) v[j] = nv ? ldg4(W + (size_t)(k0 + kr + 4 * j) * N + n0 + nc) : (f32x4){0.f, 0.f, 0.f, 0.f};
#pragma unroll
    for (int j = 0; j < 16; ++j) { float* d = scr + (kr + 4 * j) * 65 + nc; d[0] = v[j].x; d[1] = v[j].y; d[2] = v[j].z; d[3] = v[j].w; }
    LDS_WAIT();
    const int c = lane & 7;
#pragma unroll
    for (int j = 0; j < 8; ++j) {
        const int nn = (lane >> 3) + 8 * j; const float* s = scr + (8 * c) * 65 + nn;
        u32x4 o; o.x = pk2(s[0], s[65]); o.y = pk2(s[2 * 65], s[3 * 65]); o.z = pk2(s[4 * 65], s[5 * 65]); o.w = pk2(s[6 * 65], s[7 * 65]);
        const int ng = n0 + nn;
        if (ng < N) {
            const int drow = mode == 0 ? row_off + ng : ((ng >> 2) * 8 + (mode == 2 ? 4 : 0) + (ng & 3));
            *(GAS u32x4*)(WT + (size_t)drow * K + k0 + 8 * c) = o;
        }
    }
    LDS_WAIT();
}

struct Args { const float* in[39]; float* out; unsigned char* ws; int ph_lo, ph_hi; };
struct LayerW {
    const float *w_in, *w_out, *wq, *wk, *wv, *wo, *wg, *wu, *wd, *w2, *a2, *g2;
};
constexpr int CONV_NIT = 32 * 117 + 32 * 32 + 3 * (32 * 8) + 8 * 32 + 2 * (32 * 88) + 88 * 32 + 2 * 16 + 32;
__device__ __forceinline__ void convert_item(const LayerW& L, unsigned char* ws, float* scr, int it, int lane) {
    constexpr int I_IN = 32 * 117, I_OUT = 32 * 32, I_Q = 32 * 8, I_O = 8 * 32, I_G = 32 * 88, I_D = 88 * 32, I_L = 16;
    bf16* lora = (bf16*)(ws + WS_LORA);
    int r = it;
    if (r < I_IN) { tr_item(L.w_in, DM, INC, (bf16*)(ws + WS_WIN), 0, 0, scr, r, lane); return; } r -= I_IN;
    if (r < I_G) { tr_item(L.wg, DM, FF, (bf16*)(ws + WS_WGU), 1, 0, scr, r, lane); return; } r -= I_G;
    if (r < I_G) { tr_item(L.wu, DM, FF, (bf16*)(ws + WS_WGU), 2, 0, scr, r, lane); return; } r -= I_G;
    if (r < I_D) { tr_item(L.wd, FF, DM, (bf16*)(ws + WS_WD), 0, 0, scr, r, lane); return; } r -= I_D;
    if (r < I_OUT) { tr_item(L.w_out, DM, DM, (bf16*)(ws + WS_WOUT), 0, 0, scr, r, lane); return; } r -= I_OUT;
    if (r < I_Q) { tr_item(L.wq, DM, XAW, (bf16*)(ws + WS_WQ), 0, 0, scr, r, lane); return; } r -= I_Q;
    if (r < I_Q) { tr_item(L.wk, DM, XAW, (bf16*)(ws + WS_WKV), 0, 0, scr, r, lane); return; } r -= I_Q;
    if (r < I_Q) { tr_item(L.wv, DM, XAW, (bf16*)(ws + WS_WKV), 0, 512, scr, r, lane); return; } r -= I_Q;
    if (r < I_O) { tr_item(L.wo, XAW, DM, (bf16*)(ws + WS_WO), 0, 0, scr, r, lane); return; } r -= I_O;
    if (r < I_L) { tr_item(L.w2, 64, 1024, lora, 0, 0, scr, r, lane); return; } r -= I_L;
    if (r < I_L) { tr_item(L.a2, 64, 1024, lora + 65536, 0, 0, scr, r, lane); return; } r -= I_L;
    tr_item(L.g2, 128, 1024, lora + 131072, 0, 0, scr, r, lane);
}
__device__ __forceinline__ void convert_weights(const LayerW& L, unsigned char* ws, float* scr, int gw, int NGW, int lane) {
    for (int it = gw; it < CONV_NIT; it += NGW) convert_item(L, ws, scr, it, lane);
}
__device__ __forceinline__ void row_copy_cvt(const float* src, float* dstf, bf16* dstb, int lane) {
#pragma unroll
    for (int j = 0; j < 8; ++j) {
        const f32x4 v = ldg4(src + 4 * (lane + 64 * j));
        if (dstf) stg4(dstf + 4 * (lane + 64 * j), v);
        u32x2 w; w.x = pk2(v.x, v.y); w.y = pk2(v.z, v.w);
        *((GAS u32x2*)dstb + lane + 64 * j) = w;
    }
}
__device__ __forceinline__ void ln_row(const float* src, const bf16* srcb, int nparts, const float* g, const float* b, float* dstf, bf16* dstb, int lane) {
    f32x4 v[8]; float s = 0.f;
#pragma unroll
    for (int j = 0; j < 8; ++j) v[j] = srcb ? ldb4(srcb + 4 * (lane + 64 * j)) : ldg4(src + 4 * (lane + 64 * j));
    for (int p = 1; p < nparts; ++p) {
#pragma unroll
        for (int j = 0; j < 8; ++j) v[j] += ldg4(src + (size_t)p * (NSM * DM) + 4 * (lane + 64 * j));
    }
#pragma unroll
    for (int j = 0; j < 8; ++j) s += (v[j].x + v[j].y) + (v[j].z + v[j].w);
    const float mean = wave_sum(s) * (1.f / DM); float s2 = 0.f;
#pragma unroll
    for (int j = 0; j < 8; ++j) { v[j] = v[j] - mean; s2 += (v[j].x * v[j].x + v[j].y * v[j].y) + (v[j].z * v[j].z + v[j].w * v[j].w); }
    const float rstd = rsqf_(wave_sum(s2) * (1.f / DM) + 1e-5f);
#pragma unroll
    for (int j = 0; j < 8; ++j) {
        const f32x4 gg = ldg4(g + 4 * (lane + 64 * j)), bb = ldg4(b + 4 * (lane + 64 * j));
        const f32x4 y = v[j] * rstd * gg + bb;
        stg4(dstf + 4 * (lane + 64 * j), y);
        if (dstb) { u32x2 w; w.x = pk2(y.x, y.y); w.y = pk2(y.z, y.w); *((GAS u32x2*)dstb + lane + 64 * j) = w; }
    }
}

__device__ __forceinline__ void ln_row2(const bf16* sa, const bf16* sb, const float* g, const float* b, float* da, float* db, bf16* xa, bf16* xb, int lane) {
    f32x4 va[8], vb[8]; float s0 = 0.f, s1 = 0.f;
#pragma unroll
    for (int j = 0; j < 8; ++j) { va[j] = ldb4(sa + 4 * (lane + 64 * j)); vb[j] = ldb4(sb + 4 * (lane + 64 * j)); }
#pragma unroll
    for (int j = 0; j < 8; ++j) { s0 += (va[j].x + va[j].y) + (va[j].z + va[j].w); s1 += (vb[j].x + vb[j].y) + (vb[j].z + vb[j].w); }
    const float m0 = wave_sum(s0) * (1.f / DM), m1 = wave_sum(s1) * (1.f / DM); float q0 = 0.f, q1 = 0.f;
#pragma unroll
    for (int j = 0; j < 8; ++j) { va[j] = va[j] - m0; vb[j] = vb[j] - m1; q0 += dot4(va[j], va[j]); q1 += dot4(vb[j], vb[j]); }
    const float r0 = rsqf_(wave_sum(q0) * (1.f / DM) + 1e-5f), r1 = rsqf_(wave_sum(q1) * (1.f / DM) + 1e-5f);
#pragma unroll
    for (int j = 0; j < 8; ++j) {
        const f32x4 gg = ldg4(g + 4 * (lane + 64 * j)), bb = ldg4(b + 4 * (lane + 64 * j));
        const f32x4 ya = va[j] * r0 * gg + bb, yb = vb[j] * r1 * gg + bb;
        stg4(da + 4 * (lane + 64 * j), ya); stg4(db + 4 * (lane + 64 * j), yb);
        if (xa) { u32x2 w; w.x = pk2(ya.x, ya.y); w.y = pk2(ya.z, ya.w); *((GAS u32x2*)xa + lane + 64 * j) = w;
                  u32x2 w2; w2.x = pk2(yb.x, yb.y); w2.y = pk2(yb.z, yb.w); *((GAS u32x2*)xb + lane + 64 * j) = w2; }
    }
}

struct PrepArgs {
    const bf16* P; const float* state_shift; const float* state_conv;
    const float *mu, *w0, *a0, *kkw, *kaw, *convw, *alog, *dtb;
    const bf16 *W2t, *A2t, *G2t;
    float *R, *W, *K, *V, *A, *B, *G, *QG, *KG, *VG, *BETA, *GDEC;
    float *o_psh, *o_pcv, *o_ssh, *o_scv;
};
__device__ __forceinline__ void prep_rw_unit(const PrepArgs& a, LAS unsigned char* lds, int unit, int tid, int wave, int lane) {
    LAS bf16* A2 = (LAS bf16*)lds;
    LAS float* LL = (LAS float*)(lds + 32 * 264 * 2);
    const int item = unit >> 2, hq = unit & 3; const int m0 = item * 32;
    const int quad = lane >> 4, l15 = lane & 15;
    {
        const int tk = tid >> 4, c0 = (tid & 15) * 16; const int m = m0 + tk;
        const bf16* prow = a.P + (size_t)m * PLD + 3072 + c0;
        const bf16* pprev = prow - PLD; const float* sprev = nullptr; float pm = 1.f;
        if (m < NPR) { if (!(m & (SEQ - 1))) { pprev = prow; pm = 0.f; } }
        else { const int j = m - NPR; if (!(j & 3)) sprev = a.state_shift + (size_t)(j >> 2) * RWC + 3072 + c0; }
        unsigned pk[8];
#pragma unroll
        for (int q4 = 0; q4 < 4; ++q4) {
            const f32x4 p = ldb4(prow + 4 * q4); const f32x4 pv = sprev ? ldg4(sprev + 4 * q4) : ldb4(pprev + 4 * q4) * pm;
            const f32x4 mu = ldg4(a.mu + 3072 + c0 + 4 * q4);
            f32x4 x = p + (pv - p) * mu;
            const int cc = c0 + 4 * q4;
            if (cc < 64) { x.x = tanhf_(x.x); x.y = tanhf_(x.y); x.z = tanhf_(x.z); x.w = tanhf_(x.w); }
            else if (cc >= 128) { x.x = sigmoidf_(x.x); x.y = sigmoidf_(x.y); x.z = sigmoidf_(x.z); x.w = sigmoidf_(x.w); }
            pk[2 * q4] = pk2(x.x, x.y); pk[2 * q4 + 1] = pk2(x.z, x.w);
        }
        LAS u32x4* d = (LAS u32x4*)(A2 + tk * 264 + c0);
        d[0] = (u32x4){pk[0], pk[1], pk[2], pk[3]}; d[1] = (u32x4){pk[4], pk[5], pk[6], pk[7]};
    }
    __syncthreads();
    const int mt = wave & 1, nt = wave >> 1;
    const LAS bf16* arow = A2 + (mt * 16 + l15) * 264 + quad * 8;
    {
        const int h0 = hq * 4;
#pragma unroll
        for (int hh = 0; hh < 4; ++hh) {
            const int n = (h0 + hh) * 64 + nt * 16 + l15;
            f32x4 cw = {0.f, 0.f, 0.f, 0.f}, ca = cw, cg = cw;
#pragma unroll
            for (int ks = 0; ks < 2; ++ks) {
                const bf16x8 av = *(const LAS bf16x8*)(arow + 32 * ks), bv = *(const GAS bf16x8*)(a.W2t + n * 64 + 32 * ks + quad * 8);
                cw = __builtin_amdgcn_mfma_f32_16x16x32_bf16(av, bv, cw, 0, 0, 0);
                const bf16x8 av2 = *(const LAS bf16x8*)(arow + 64 + 32 * ks), bv2 = *(const GAS bf16x8*)(a.A2t + n * 64 + 32 * ks + quad * 8);
                ca = __builtin_amdgcn_mfma_f32_16x16x32_bf16(av2, bv2, ca, 0, 0, 0);
            }
#pragma unroll
            for (int ks = 0; ks < 4; ++ks) {
                const bf16x8 av = *(const LAS bf16x8*)(arow + 128 + 32 * ks), bv = *(const GAS bf16x8*)(a.G2t + n * 128 + 32 * ks + quad * 8);
                cg = __builtin_amdgcn_mfma_f32_16x16x32_bf16(av, bv, cg, 0, 0, 0);
            }
#pragma unroll
            for (int j = 0; j < 4; ++j) {
                const int o = hh * (3 * 32 * 68) + (mt * 16 + quad * 4 + j) * 68 + nt * 16 + l15;
                LL[o] = cw[j]; LL[32 * 68 + o] = ca[j]; LL[2 * 32 * 68 + o] = cg[j];
            }
        }
        __syncthreads();
        {
            const int tk = wave * 4 + (lane >> 4); const int m = m0 + tk;
            const bf16* prow = a.P + (size_t)m * PLD;
            const bf16* pprev = prow - PLD; const float* sprev = nullptr; float pm = 1.f;
            if (m < NPR) { if (!(m & (SEQ - 1))) { pprev = prow; pm = 0.f; } }
            else { const int j = m - NPR; if (!(j & 3)) sprev = a.state_shift + (size_t)(j >> 2) * RWC; }
            f32x4 pr[4], pk_[4], pv[4], qr[4], qk[4], qv[4];
#pragma unroll
            for (int hh = 0; hh < 4; ++hh) { const int col = (h0 + hh) * 64 + 4 * l15;
                pr[hh] = ldb4(prow + col); pk_[hh] = ldb4(prow + 1024 + col); pv[hh] = ldb4(prow + 2048 + col);
                if (sprev) { qr[hh] = ldg4(sprev + col); qk[hh] = ldg4(sprev + 1024 + col); qv[hh] = ldg4(sprev + 2048 + col); }
                else { qr[hh] = ldb4(pprev + col) * pm; qk[hh] = ldb4(pprev + 1024 + col) * pm; qv[hh] = ldb4(pprev + 2048 + col) * pm; } }
#pragma unroll
            for (int hh = 0; hh < 4; ++hh) {
                const int col = (h0 + hh) * 64 + 4 * l15;
                const f32x4 mur = ldg4(a.mu + col), muk = ldg4(a.mu + 1024 + col), muv = ldg4(a.mu + 2048 + col);
                const f32x4 w0 = ldg4(a.w0 + col), a0 = ldg4(a.a0 + col), kkw = ldg4(a.kkw + col), kaw = ldg4(a.kaw + col);
                const LAS float* L0 = LL + hh * (3 * 32 * 68) + tk * 68 + 4 * l15;
                const f32x4 lw4 = *(const LAS f32x4*)L0, la4 = *(const LAS f32x4*)(L0 + 32 * 68), g4 = *(const LAS f32x4*)(L0 + 2 * 32 * 68);
                const f32x4 r4 = pr[hh] + (qr[hh] - pr[hh]) * mur, k4 = pk_[hh] + (qk[hh] - pk_[hh]) * muk, v4 = pv[hh] + (qv[hh] - pv[hh]) * muv;
                const f32x4 kkv = k4 * kkw;
                const float n2 = reduce16(dot4(kkv, kkv)); const float rn = rsqf_(n2 + 1e-12f);
                f32x4 dec, k2, am, bm;
#pragma unroll
                for (int e = 0; e < 4; ++e) {
                    const float lw = lw4[e] + w0[e];
                    const float wlog = -softplusf_(-lw) - 0.5f;
                    dec[e] = __expf(-__expf(wlog));
                    const float av = sigmoidf_(a0[e] + la4[e]);
                    const float kk = kkv[e] * rn;
                    k2[e] = k4[e] * (1.0f + (av - 1.0f) * kaw[e]);
                    am[e] = -kk; bm[e] = kk * av;
                }
                const size_t o = (size_t)m * 1024 + col;
                stg4(a.R + o, r4); stg4(a.W + o, dec); stg4(a.K + o, k2); stg4(a.V + o, v4); stg4(a.A + o, am); stg4(a.B + o, bm); stg4(a.G + o, g4);
            }
        }
        __syncthreads();
    }
}
__device__ __forceinline__ void prep_gd_pair(const PrepArgs& a, int q, int lane) {
    const int m = q >> 2, hp = q & 3; const int h = 2 * hp + (lane >> 5), c4 = 4 * (lane & 31);
    int t, sbase; const float* cprev;
    if (m < NPR) { t = m & (SEQ - 1); sbase = m - t; cprev = nullptr; }
    else { const int j = m - NPR; t = j & 3; sbase = m - t; cprev = a.state_conv + (size_t)(j >> 2) * 3 * 3072; }
    f32x4 acc[3];
#pragma unroll
    for (int s3 = 0; s3 < 3; ++s3) acc[s3] = (f32x4){0.f, 0.f, 0.f, 0.f};
#pragma unroll
    for (int j = 0; j < 4; ++j) {
        const int xi = t + j; const bf16* src = a.P + (size_t)m * PLD + GD0; const float* fsrc = nullptr; float fm = 1.f;
        if (xi >= 3) src = a.P + (size_t)(sbase + xi - 3) * PLD + GD0;
        else if (cprev) fsrc = cprev + (size_t)xi * 3072;
        else fm = 0.f;
#pragma unroll
        for (int s3 = 0; s3 < 3; ++s3) { const int cc = s3 * 1024 + h * 128 + c4; const f32x4 x = fsrc ? ldg4(fsrc + cc) : ldb4(src + cc) * fm; acc[s3] += x * ldg4(a.convw + j * 3072 + cc); }
    }
#pragma unroll
    for (int s3 = 0; s3 < 3; ++s3)
#pragma unroll
        for (int e = 0; e < 4; ++e) { const float x = acc[s3][e]; acc[s3][e] = x * sigmoidf_(x); }
    float qn = reduce16(dot4(acc[0], acc[0])), kn = reduce16(dot4(acc[1], acc[1]));
    qn += __shfl_xor(qn, 16); kn += __shfl_xor(kn, 16);
    const float qs = rsqf_(qn + 1e-12f) * 0.08838834764831845f, ks = rsqf_(kn + 1e-12f);
    const size_t o = (size_t)m * 1024 + h * 128 + c4;
    stg4(a.QG + o, acc[0] * qs); stg4(a.KG + o, acc[1] * ks); stg4(a.VG + o, acc[2]);
    if ((lane & 31) == 0) {
        const float braw = ldb1(a.P + (size_t)m * PLD + GD0 + 4096 + h), araw = ldb1(a.P + (size_t)m * PLD + GD0 + 4104 + h);
        stg1(a.BETA + (size_t)m * 1024 + h * 2, sigmoidf_(braw));
        stg1(a.BETA + (size_t)m * 1024 + h * 2 + 1, __expf(-__expf(ldg1(a.alog + h)) * softplusf_(araw + ldg1(a.dtb + h))));
    }
}
__device__ __forceinline__ void prep_copy_unit(const PrepArgs& a, int u, int lane) {
    const bf16* src; float* dst; int n4;
    if (u < 396) { const int seq = u / 3, i = u - seq * 3; n4 = 768;
        if (seq < 4) { src = a.P + (size_t)(seq * SEQ + SEQ - 3 + i) * PLD + GD0; dst = a.o_pcv + (size_t)(seq * 3 + i) * 3072; }
        else { const int b = seq - 4; src = a.P + (size_t)(NPR + 4 * b + 1 + i) * PLD + GD0; dst = a.o_scv + (size_t)(b * 3 + i) * 3072; } }
    else { const int v = u - 396; n4 = 832;
        if (v < 4) { src = a.P + (size_t)(v * SEQ + SEQ - 1) * PLD; dst = a.o_psh + (size_t)v * RWC; }
        else { const int b = v - 4; src = a.P + (size_t)(NPR + 4 * b + 3) * PLD; dst = a.o_ssh + (size_t)b * RWC; } }
    for (int c = lane; c < n4; c += 64) stg4(dst + 4 * c, ldb4(src + 4 * c));
}

struct ScanArgs {
    const float *R, *W, *K, *V, *A, *B, *QG, *KG, *VG, *BETA, *GDEC;
    const float *st_rw, *st_gd;
    float *ORW, *OGD;
    float *o_prw, *o_pgd, *o_srw, *o_sgd;
};
constexpr int TC = 16, RW_STEP = 336, GD_STEP = 276, SC_BUF = TC * (RW_STEP + GD_STEP);
__device__ __forceinline__ unsigned sc_slot(bool rw, int i, int t2, int m0, int h, int part) {
    const int idx = t2 + 256 * i; unsigned eo = 0u;
    if (rw) {
        if (idx < TC * 84) {
            const int stp = idx / 84, f4 = idx - stp * 84; const int vec = f4 >> 4, o4 = (f4 & 15) * 4;
            const unsigned arr = vec == 0 ? 1u : vec == 1 ? 4u : vec == 2 ? 5u : vec == 3 ? 2u : vec == 4 ? 0u : 3u;
            eo = arr * SCBF + (unsigned)(m0 + stp) * 1024u + h * 64 + (vec == 5 ? part * 16 + o4 : o4);
        }
    } else {
        if (i < 5 && idx < TC * 69) {
            const int stp = idx / 69, f4 = idx - stp * 69; const unsigned rb = (unsigned)(m0 + stp) * 1024u;
            if (f4 < 32) eo = 8u * SCBF + rb + h * 128 + f4 * 4;
            else if (f4 < 64) eo = 7u * SCBF + rb + h * 128 + (f4 - 32) * 4;
            else if (f4 < 68) eo = 9u * SCBF + rb + h * 128 + part * 16 + (f4 - 64) * 4;
            else eo = 10u * SCBF + rb + h * 2;
        }
    }
    return eo * 4u;
}
__device__ __forceinline__ f32x4 sc_load(const float* base, unsigned boff, int c) {
    return *(const GAS f32x4*)((const GAS char*)base + (boff + (unsigned)c * (TC * 1024u * 4u)));
}
__device__ __forceinline__ void sc_store(LAS float* bf, bool rw, int i, int t2, f32x4 v) {
    const int idx = t2 + 256 * i;
    if (rw) { if (idx < TC * 84) { const int stp = idx / 84, f4 = idx - stp * 84; *(LAS f32x4*)(bf + stp * RW_STEP + f4 * 4) = v; } }
    else { if (i < 5 && idx < TC * 69) { const int stp = idx / 69, f4 = idx - stp * 69; *(LAS f32x4*)(bf + TC * RW_STEP + stp * GD_STEP + f4 * 4) = v; } }
}
template <int NI> __device__ __forceinline__ void scan_sample_rw(const ScanArgs& a, int q, int lane) {
    const int grp16 = lane >> 4, l15 = lane & 15, ks = l15 * 4;
    f32x4 s[NI], w[NI][4], av[NI][4], bv[NI][4], kv[NI][4], rv[NI][4]; float vv[NI][4]; size_t so[NI]; int m0[NI], oc[NI];
#pragma unroll
    for (int ii = 0; ii < NI; ++ii) {
        const int j = NI * q + ii; const int bh = j >> 4, g = j & 15; const int b = bh >> 4, h = bh & 15; const int row = 4 * g + grp16;
        m0[ii] = NPR + 4 * b; oc[ii] = h * 64 + row; so[ii] = (size_t)bh * 4096 + row * 64 + ks;
        s[ii] = ldg4(a.st_rw + so[ii]);
#pragma unroll
        for (int t = 0; t < 4; ++t) { const size_t o = (size_t)(m0[ii] + t) * 1024 + h * 64;
            w[ii][t] = ldg4(a.W + o + ks); av[ii][t] = ldg4(a.A + o + ks); bv[ii][t] = ldg4(a.B + o + ks); kv[ii][t] = ldg4(a.K + o + ks); rv[ii][t] = ldg4(a.R + o + ks); vv[ii][t] = ldg1(a.V + o + row); }
    }
#pragma unroll
    for (int ii = 0; ii < NI; ++ii) {
        float osave = 0.f;
#pragma unroll
        for (int t = 0; t < 4; ++t) {
            const float sa = reduce16(dot4(s[ii], av[ii][t]));
            s[ii] = s[ii] * w[ii][t] + (bv[ii][t] * sa + kv[ii][t] * vv[ii][t]);
            const float o = reduce16(dot4(s[ii], rv[ii][t]));
            osave = (l15 == t) ? o : osave;
        }
        if (l15 < 4) stg1(a.ORW + (size_t)(m0[ii] + l15) * 1024 + oc[ii], osave);
        stg4(a.o_srw + so[ii], s[ii]);
    }
}
template <int NI> __device__ __forceinline__ void scan_sample_gd(const ScanArgs& a, int q, int lane) {
    const int grp16 = lane >> 4, l15 = lane & 15, ks = l15 * 8;
    f32x4 s0[NI], s1[NI], k0[NI][4], k1[NI][4], q0[NI][4], q1[NI][4]; float vv[NI][4], be[NI][4], gd[NI][4]; size_t so[NI]; int m0[NI], oc[NI];
#pragma unroll
    for (int ii = 0; ii < NI; ++ii) {
        const int j = NI * q + ii; const int bh = j >> 5, g = j & 31; const int b = bh >> 3, h = bh & 7; const int col = 4 * g + grp16;
        m0[ii] = NPR + 4 * b; oc[ii] = h * 128 + col; so[ii] = (size_t)bh * 16384 + (size_t)ks * 128 + col;
        const float* sp = a.st_gd + so[ii];
        s0[ii] = (f32x4){ldg1(sp), ldg1(sp + 128), ldg1(sp + 256), ldg1(sp + 384)}; s1[ii] = (f32x4){ldg1(sp + 512), ldg1(sp + 640), ldg1(sp + 768), ldg1(sp + 896)};
#pragma unroll
        for (int t = 0; t < 4; ++t) { const int m = m0[ii] + t; const size_t o = (size_t)m * 1024 + h * 128;
            k0[ii][t] = ldg4(a.KG + o + ks); k1[ii][t] = ldg4(a.KG + o + ks + 4); q0[ii][t] = ldg4(a.QG + o + ks); q1[ii][t] = ldg4(a.QG + o + ks + 4);
            vv[ii][t] = ldg1(a.VG + o + col); be[ii][t] = ldg1(a.BETA + (size_t)m * 1024 + h * 2); gd[ii][t] = ldg1(a.BETA + (size_t)m * 1024 + h * 2 + 1); }
    }
#pragma unroll
    for (int ii = 0; ii < NI; ++ii) {
        float osave = 0.f;
#pragma unroll
        for (int t = 0; t < 4; ++t) {
            const float d = reduce16(dot8(s0[ii], s1[ii], k0[ii][t], k1[ii][t]));
            const float gdec = gd[ii][t]; const float cc = be[ii][t] * (vv[ii][t] - gdec * d);
            s0[ii] = s0[ii] * gdec + k0[ii][t] * cc; s1[ii] = s1[ii] * gdec + k1[ii][t] * cc;
            const float o = reduce16(dot8(s0[ii], s1[ii], q0[ii][t], q1[ii][t]));
            osave = (l15 == t) ? o : osave;
        }
        if (l15 < 4) stg1(a.OGD + (size_t)(m0[ii] + l15) * 1024 + oc[ii], osave);
        float* sp = a.o_sgd + so[ii];
        stg1(sp, s0[ii].x); stg1(sp + 128, s0[ii].y); stg1(sp + 256, s0[ii].z); stg1(sp + 384, s0[ii].w);
        stg1(sp + 512, s1[ii].x); stg1(sp + 640, s1[ii].y); stg1(sp + 768, s1[ii].z); stg1(sp + 896, s1[ii].w);
    }
}

__device__ __forceinline__ void scan_prompt(const ScanArgs& a, LAS unsigned char* lds, int it, int tid, int wave, int lane, int hw, bool conv, const Args& args, unsigned char* convdst) {
    LAS float* buf = (LAS float*)lds;
    const bool rw = tid < 256; const int t2 = tid & 255;
    const int l15 = lane & 15, grp16 = lane >> 4;
    const int bh_r = it >> 2, part_r = it & 3, b_r = bh_r >> 4, h_r = bh_r & 15;
    const int bh_g = it >> 3, part_g = it & 7, b_g = bh_g >> 3, h_g = bh_g & 7;
    const int m0l = (rw ? b_r : b_g) * SEQ, hl = rw ? h_r : h_g, partl = rw ? part_r : part_g;
    unsigned e0 = sc_slot(rw, 0, t2, m0l, hl, partl); asm volatile("" : "+v"(e0));
    unsigned e1 = sc_slot(rw, 1, t2, m0l, hl, partl); asm volatile("" : "+v"(e1));
    unsigned e2 = sc_slot(rw, 2, t2, m0l, hl, partl); asm volatile("" : "+v"(e2));
    unsigned e3 = sc_slot(rw, 3, t2, m0l, hl, partl); asm volatile("" : "+v"(e3));
    unsigned e4 = sc_slot(rw, 4, t2, m0l, hl, partl); asm volatile("" : "+v"(e4));
    unsigned e5 = sc_slot(rw, 5, t2, m0l, hl, partl); asm volatile("" : "+v"(e5));
    constexpr int nch = SEQ / TC;
    f32x4 st0, st1, st2, st3, st4, st5;
#define SC_LOAD_ALL(c_) do { const int cc_ = (c_); st0 = sc_load(a.R, e0, cc_); st1 = sc_load(a.R, e1, cc_); st2 = sc_load(a.R, e2, cc_); st3 = sc_load(a.R, e3, cc_); st4 = sc_load(a.R, e4, cc_); st5 = sc_load(a.R, e5, cc_); } while (0)
#define SC_STORE_ALL(bf_) do { LAS float* b_ = (bf_); sc_store(b_, rw, 0, t2, st0); sc_store(b_, rw, 1, t2, st1); sc_store(b_, rw, 2, t2, st2); sc_store(b_, rw, 3, t2, st3); sc_store(b_, rw, 4, t2, st4); sc_store(b_, rw, 5, t2, st5); } while (0)
    f32x4 sa0 = {0.f, 0.f, 0.f, 0.f}, sa1 = sa0, sb0 = sa0, sb1 = sa0;
    const int cw = wave & 1;
    const int rl = cw * 8 + grp16 * 2;
    const int rc = (wave < 2 ? part_g : part_r) * 16 + rl;
    SC_LOAD_ALL(0); SC_STORE_ALL(buf); __syncthreads();
    if (wave < 4) __builtin_amdgcn_s_setprio(3);
    for (int c = 0; c < nch; ++c) {
        LAS float* cur = buf + (c & 1) * SC_BUF;
        if (c + 1 < nch) SC_LOAD_ALL(c + 1);
        float* op = nullptr; f32x2 ov = {0.f, 0.f};
        if (wave >= 4) {
            int lane2 = lane; asm volatile("" : "+v"(lane2));
            if (c & 1) { const int u = hw + 1024 * (c >> 1); if (u < 32768) scan_sample_rw<1>(a, u, lane2); else scan_sample_gd<1>(a, u - 32768, lane2); }
            if (conv && (c & 7) == 2 && c < 112) { const int ci = hw + 1024 * (c >> 3);
#define INL(i) ({ int _i = (i); asm volatile("" : "+s"(_i)); args.in[_i]; })
                const LayerW L1{INL(9) + (size_t)DM * INC, INL(25) + (size_t)DM * DM, INL(28) + (size_t)DM * XAW, INL(29) + (size_t)DM * XAW, INL(30) + (size_t)DM * XAW,
                                INL(31) + (size_t)XAW * DM, INL(34) + (size_t)DM * FF, INL(35) + (size_t)DM * FF, INL(36) + (size_t)FF * DM, INL(12) + 65536, INL(14) + 65536, INL(15) + 131072};
                if (ci < CONV_NIT) convert_item(L1, convdst, (float*)((unsigned char*)lds + 2 * SC_BUF * 4) + (wave - 4) * 4160, ci, lane2); }
        } else if (wave == 2 || wave == 3) {
            const LAS float* bs = cur + l15 * 4; const LAS float* bv = cur + 320 + rl;
            float osa = 0.f, osb = 0.f;
            f32x4 w4 = *(const LAS f32x4*)bs, a4 = *(const LAS f32x4*)(bs + 64), b4 = *(const LAS f32x4*)(bs + 128), k4 = *(const LAS f32x4*)(bs + 192), r4 = *(const LAS f32x4*)(bs + 256);
            f32x2 vv = *(const LAS f32x2*)bv;
#pragma unroll
            for (int stp = 0; stp < TC; ++stp) {
                f32x4 nw = w4, na = a4, nb = b4, nk = k4, nr = r4; f32x2 nv = vv;
                if (stp + 1 < TC) { const LAS float* p = bs + (stp + 1) * RW_STEP;
                    nw = *(const LAS f32x4*)p; na = *(const LAS f32x4*)(p + 64); nb = *(const LAS f32x4*)(p + 128); nk = *(const LAS f32x4*)(p + 192); nr = *(const LAS f32x4*)(p + 256); nv = *(const LAS f32x2*)(bv + (stp + 1) * RW_STEP); }
                const float da = reduce16(dot4(sa0, a4)), db = reduce16(dot4(sb0, a4));
                sa0 = sa0 * w4 + (b4 * da + k4 * vv.x); sb0 = sb0 * w4 + (b4 * db + k4 * vv.y);
                const float oa = reduce16(dot4(sa0, r4)), ob = reduce16(dot4(sb0, r4));
                osa = (l15 == stp) ? oa : osa; osb = (l15 == stp) ? ob : osb;
                w4 = nw; a4 = na; b4 = nb; k4 = nk; r4 = nr; vv = nv;
            }
            op = a.ORW + (size_t)(b_r * SEQ + c * TC + l15) * 1024 + h_r * 64 + rc; ov = (f32x2){osa, osb};
        } else if (wave < 2) {
            const LAS float* bs = cur + TC * RW_STEP + l15 * 8; const LAS float* bv = cur + TC * RW_STEP + 256 + rl; const LAS float* bg = cur + TC * RW_STEP + 272;
            float osa = 0.f, osb = 0.f;
            f32x4 k0 = *(const LAS f32x4*)bs, k1 = *(const LAS f32x4*)(bs + 4), q0 = *(const LAS f32x4*)(bs + 128), q1 = *(const LAS f32x4*)(bs + 132);
            f32x2 vv = *(const LAS f32x2*)bv; f32x2 bg2 = *(const LAS f32x2*)bg;
#pragma unroll
            for (int stp = 0; stp < TC; ++stp) {
                f32x4 nk0 = k0, nk1 = k1, nq0 = q0, nq1 = q1; f32x2 nv = vv; f32x2 nbg = bg2;
                if (stp + 1 < TC) { const LAS float* p = bs + (stp + 1) * GD_STEP;
                    nk0 = *(const LAS f32x4*)p; nk1 = *(const LAS f32x4*)(p + 4); nq0 = *(const LAS f32x4*)(p + 128); nq1 = *(const LAS f32x4*)(p + 132); nv = *(const LAS f32x2*)(bv + (stp + 1) * GD_STEP); nbg = *(const LAS f32x2*)(bg + (stp + 1) * GD_STEP); }
                const float da = reduce16(dot8(sa0, sa1, k0, k1)), db = reduce16(dot8(sb0, sb1, k0, k1));
                const float gdec = bg2.y; const float ca = bg2.x * (vv.x - gdec * da), cb = bg2.x * (vv.y - gdec * db);
                sa0 = sa0 * gdec + k0 * ca; sa1 = sa1 * gdec + k1 * ca; sb0 = sb0 * gdec + k0 * cb; sb1 = sb1 * gdec + k1 * cb;
                const float oa = reduce16(dot8(sa0, sa1, q0, q1)), ob = reduce16(dot8(sb0, sb1, q0, q1));
                osa = (l15 == stp) ? oa : osa; osb = (l15 == stp) ? ob : osb;
                k0 = nk0; k1 = nk1; q0 = nq0; q1 = nq1; vv = nv; bg2 = nbg;
            }
            op = a.OGD + (size_t)(b_g * SEQ + c * TC + l15) * 1024 + h_g * 128 + rc; ov = (f32x2){osa, osb};
        }
        if (c + 1 < nch) SC_STORE_ALL(buf + ((c + 1) & 1) * SC_BUF);
        if (wave < 4) *(GAS f32x2*)op = ov;
        asm volatile("s_waitcnt lgkmcnt(0)" ::: "memory"); __builtin_amdgcn_s_barrier(); asm volatile("" ::: "memory");
    }
    __builtin_amdgcn_s_setprio(0);
    if (wave == 2 || wave == 3) { float* sp = a.o_prw + (size_t)bh_r * 4096 + rc * 64 + l15 * 4; stg4(sp, sa0); stg4(sp + 64, sb0); }
    else if (wave < 2) { float* sp = a.o_pgd + (size_t)bh_g * 16384 + (size_t)(l15 * 8) * 128 + rc;
#pragma unroll
        for (int e = 0; e < 4; ++e) { *(GAS f32x2*)(sp + (size_t)e * 128) = (f32x2){sa0[e], sb0[e]}; *(GAS f32x2*)(sp + (size_t)(4 + e) * 128) = (f32x2){sa1[e], sb1[e]}; } }
}

struct PostArgs {
    const bf16* P; const float *R, *K, *V, *G, *ORW, *OGD; const float *rk, *lnxw, *lnxb, *normw; bf16* MIX;
};
__device__ __forceinline__ void post_row(const PostArgs& a, int m, int lane) {
    const size_t rb = (size_t)m * 1024;
    f32x4 o[4], r[4], k[4], v[4], g[4];
#pragma unroll
    for (int j = 0; j < 4; ++j) { const int col = j * 256 + 4 * lane;
        o[j] = ldg4(a.ORW + rb + col); r[j] = ldg4(a.R + rb + col); k[j] = ldg4(a.K + rb + col); v[j] = ldg4(a.V + rb + col); g[j] = ldg4(a.G + rb + col); }
#pragma unroll
    for (int j = 0; j < 4; ++j) { const int col = j * 256 + 4 * lane;
        const f32x4 lw = ldg4(a.lnxw + col), lb = ldg4(a.lnxb + col), rk = ldg4(a.rk + col);
        const float mu = reduce16((o[j].x + o[j].y) + (o[j].z + o[j].w)) * (1.f / 64.f); const f32x4 d = o[j] - mu;
        const float var = reduce16(dot4(d, d)) * (1.f / 64.f); const float rs = rsqf_(var + 64e-5f);
        const float bs = reduce16(dot4(r[j] * k[j], rk));
        const f32x4 y = (d * rs * lw + lb + v[j] * bs) * g[j];
        u32x2 w; w.x = pk2(y.x, y.y); w.y = pk2(y.z, y.w);
        *(GAS u32x2*)(a.MIX + (size_t)m * DM + col) = w; }
    f32x4 og[4], z[4];
#pragma unroll
    for (int j = 0; j < 4; ++j) { const int col = j * 256 + 4 * lane; og[j] = ldg4(a.OGD + rb + col); z[j] = ldb4(a.P + (size_t)m * PLD + GD0 + 3072 + col); }
    const f32x4 nw = ldg4(a.normw + 4 * (lane & 31));
#pragma unroll
    for (int j = 0; j < 4; ++j) { const int col = j * 256 + 4 * lane;
        float ms = reduce16(dot4(og[j], og[j])); ms += __shfl_xor(ms, 16); const float rs = rsqf_(ms * (1.f / 128.f) + 1e-6f);
        f32x4 y;
#pragma unroll
        for (int e = 0; e < 4; ++e) y[e] = og[j][e] * rs * nw[e] * (z[j][e] * sigmoidf_(z[j][e]));
        u32x2 w; w.x = pk2(y.x, y.y); w.y = pk2(y.z, y.w);
        *(GAS u32x2*)(a.MIX + (size_t)m * DM + 1024 + col) = w; }
}

constexpr int KP = 136, VP = 132;
__device__ __forceinline__ void attn_unit(const float* Kp, const float* Vp, const float* Q, bf16* AO, int mrow0, int nvalid, bool all_waves, int hcol,
                                          unsigned char* lds, int tid, int wave, int lane) {
    bf16* Ks = (bf16*)lds; bf16* Vs = Ks + 256 * KP;
#pragma unroll
    for (int i0 = 0; i0 < 16; i0 += 8) {
        f32x4 kk8[8], vv8[8];
#pragma unroll
        for (int j = 0; j < 8; ++j) { const int idx = tid + NTHR * (i0 + j); const int key = idx >> 5, d4 = (idx & 31) * 4;
            kk8[j] = ldg4(Kp + (size_t)key * 512 + d4); vv8[j] = ldg4(Vp + (size_t)key * 512 + d4); }
#pragma unroll
        for (int j = 0; j < 8; ++j) { const int idx = tid + NTHR * (i0 + j); const int key = idx >> 5, d4 = (idx & 31) * 4;
            const f32x4 kv = kk8[j], vv = vv8[j];
            u32x2 a, b; a.x = pk2(kv.x, kv.y); a.y = pk2(kv.z, kv.w); b.x = pk2(vv.x, vv.y); b.y = pk2(vv.z, vv.w);
            *(u32x2*)(Ks + key * KP + d4) = a; *(u32x2*)(Vs + key * VP + d4) = b; }
    }
    __syncthreads();
    if (all_waves || wave == 0) {
        const int quad = lane >> 4, l15 = lane & 15;
        const int qr = (all_waves ? wave * 16 : 0) + l15; const bool valid = qr < nvalid; const int m = mrow0 + qr;
        bf16x8 qf[4];
#pragma unroll
        for (int ds = 0; ds < 4; ++ds) {
            f32x4 x0 = {0.f, 0.f, 0.f, 0.f}, x1 = x0;
            if (valid) { const float* qp = Q + (size_t)m * XAW + hcol + 32 * ds + quad * 8; x0 = ldg4(qp); x1 = ldg4(qp + 4); }
            u32x4 w; w.x = pk2(x0.x, x0.y); w.y = pk2(x0.z, x0.w); w.z = pk2(x1.x, x1.y); w.w = pk2(x1.z, x1.w);
            qf[ds] = __builtin_bit_cast(bf16x8, w);
        }
        f32x4 sc[16];
#pragma unroll
        for (int kt = 0; kt < 16; ++kt) {
            sc[kt] = (f32x4){0.f, 0.f, 0.f, 0.f};
#pragma unroll
            for (int ds = 0; ds < 4; ++ds) {
                const bf16x8 kf = *(const bf16x8*)(Ks + (16 * kt + l15) * KP + 32 * ds + quad * 8);
                sc[kt] = __builtin_amdgcn_mfma_f32_16x16x32_bf16(kf, qf[ds], sc[kt], 0, 0, 0);
            }
        }
        float mx = -3.0e38f;
#pragma unroll
        for (int kt = 0; kt < 16; ++kt) mx = fmaxf(mx, fmaxf(fmaxf(sc[kt].x, sc[kt].y), fmaxf(sc[kt].z, sc[kt].w)));
        mx = fmaxf(mx, __shfl_xor(mx, 16)); mx = fmaxf(mx, __shfl_xor(mx, 32));
        const float c2 = 0.08838834764831845f * 1.4426950408889634f; float sum = 0.f;
        bf16x8 pb[8];
#pragma unroll
        for (int ks = 0; ks < 8; ++ks) {
            float p[8];
#pragma unroll
            for (int e = 0; e < 4; ++e) { p[e] = exp2f((sc[2 * ks][e] - mx) * c2); p[4 + e] = exp2f((sc[2 * ks + 1][e] - mx) * c2); }
            sum += ((p[0] + p[1]) + (p[2] + p[3])) + ((p[4] + p[5]) + (p[6] + p[7]));
            u32x4 w; w.x = pk2(p[0], p[1]); w.y = pk2(p[2], p[3]); w.z = pk2(p[4], p[5]); w.w = pk2(p[6], p[7]);
            pb[ks] = __builtin_bit_cast(bf16x8, w);
        }
        sum += __shfl_xor(sum, 16); sum += __shfl_xor(sum, 32);
        const float inv = rcpf_(sum);
#pragma unroll
        for (int nt = 0; nt < 8; ++nt) {
            f32x4 o = {0.f, 0.f, 0.f, 0.f};
            const bf16* vcol = Vs + 16 * nt + l15;
#pragma unroll
            for (int ks = 0; ks < 8; ++ks) {
                const bf16* v0 = vcol + (32 * ks + 4 * quad) * VP; const bf16* v1 = v0 + 16 * VP;
                u32x4 w;
                w.x = (unsigned)v0[0] | ((unsigned)v0[VP] << 16); w.y = (unsigned)v0[2 * VP] | ((unsigned)v0[3 * VP] << 16);
                w.z = (unsigned)v1[0] | ((unsigned)v1[VP] << 16); w.w = (unsigned)v1[2 * VP] | ((unsigned)v1[3 * VP] << 16);
                o = __builtin_amdgcn_mfma_f32_16x16x32_bf16(__builtin_bit_cast(bf16x8, w), pb[ks], o, 0, 0, 0);
            }
            if (valid) { u32x2 w; w.x = pk2(o.x * inv, o.y * inv); w.y = pk2(o.z * inv, o.w * inv); *(GAS u32x2*)(AO + (size_t)m * XAW + hcol + 16 * nt + quad * 4) = w; }
        }
    }
    __syncthreads();
}

#define RLX_AGENT __ATOMIC_RELAXED, __HIP_MEMORY_SCOPE_AGENT
#define XB_TMO      128
#define XB_XCNT(j)  (256  + 64 * (j))
#define XB_XSUB(j)  (1280 + 64 * (j))
#define XB_XGEN(j)  (2304 + 64 * (j))
#define XB_TOP      3328
#define XB_TOPGEN   3392
#define XCD_BAR_WORDS 3456
#define XB_SPIN_CAP (1u << 18)

__device__ __forceinline__ unsigned xb_ld(unsigned* p)              { return __hip_atomic_load(p, __ATOMIC_RELAXED, __HIP_MEMORY_SCOPE_AGENT); }
__device__ __forceinline__ unsigned xb_add(unsigned* p, unsigned v) { return __hip_atomic_fetch_add(p, v, __ATOMIC_RELAXED, __HIP_MEMORY_SCOPE_AGENT); }
__device__ __forceinline__ unsigned xb_xcc_id() { return (unsigned)__builtin_amdgcn_s_getreg((3 << 11) | 20) & 0xFu; }
#define XB_SPIN(cond, bar) do { unsigned _sp = 0; while (cond) { __builtin_amdgcn_s_sleep(1); \
    if ((++_sp & 255u) == 0u) { if (xb_ld(&(bar)[XB_TMO])) break; if (_sp > XB_SPIN_CAP) { atomicAdd(&(bar)[XB_TMO], 1u); break; } } } } while (0)

struct XcdBarrier {
    unsigned* bar; unsigned x;
    volatile LAS unsigned* st;
};

__device__ __forceinline__ XcdBarrier xcd_barrier_post(unsigned* bar, volatile LAS unsigned* st) {
    XcdBarrier b; b.bar = bar; b.x = xb_xcc_id(); b.st = st;
    if (threadIdx.x == 0) (void)xb_add(&bar[XB_XCNT(b.x)], 1u);
    return b;
}
__device__ __forceinline__ void xcd_barrier_complete(unsigned* bar, unsigned x, unsigned& nloc, unsigned& nx) {
    const unsigned G = gridDim.x * gridDim.y * gridDim.z;
    unsigned sum, cnt, mine, sp = 0u;
    for (;;) {
        sum = 0u; cnt = 0u; mine = 0u;
#pragma unroll
        for (unsigned j = 0; j < 16; ++j) { const unsigned c = xb_ld(&bar[XB_XCNT(j)]); sum += c; cnt += (c > 0u) ? 1u : 0u; mine = (j == x) ? c : mine; }
        if (sum == G) break;
        __builtin_amdgcn_s_sleep(1);
        if ((++sp & 255u) == 0u) { if (xb_ld(&bar[XB_TMO])) break; if (sp > XB_SPIN_CAP) { atomicAdd(&bar[XB_TMO], 1u); break; } }
    }
    nloc = mine > 0u ? mine : 1u; nx = cnt > 0u ? cnt : 1u;
}

__device__ __forceinline__ void xcd_barrier(const XcdBarrier& b) {
    asm volatile("s_waitcnt vmcnt(0)" ::: "memory");
    __syncthreads();
    if (threadIdx.x == 0) {
        unsigned* bar = b.bar;
        __builtin_amdgcn_s_waitcnt(0);
        unsigned nloc = b.st[0], nx = b.st[1];
        if (nloc == 0u) { xcd_barrier_complete(bar, b.x, nloc, nx); b.st[0] = nloc; b.st[1] = nx; }
        const unsigned old = xb_add(&bar[XB_XSUB(b.x)], 1u);
        const unsigned gen = old / nloc;
        if (old + 1u == (gen + 1u) * nloc) {
            __builtin_amdgcn_fence(__ATOMIC_RELEASE, "agent");
            asm volatile("s_waitcnt vmcnt(0)" ::: "memory");
            const unsigned og = xb_add(&bar[XB_TOP], 1u);
            const unsigned tg = og / nx;
            if (og + 1u == (tg + 1u) * nx) xb_add(&bar[XB_TOPGEN], 1u);
            else XB_SPIN(xb_ld(&bar[XB_TOPGEN]) == tg, bar);
            __builtin_amdgcn_fence(__ATOMIC_ACQUIRE, "agent");
            xb_add(&bar[XB_XGEN(b.x)], 1u);
            asm volatile("s_waitcnt vmcnt(0)" ::: "memory");
        } else {
            XB_SPIN(xb_ld(&bar[XB_XGEN(b.x)]) == gen, bar);
            __builtin_amdgcn_fence(__ATOMIC_ACQUIRE, "agent");
            asm volatile("s_waitcnt vmcnt(0)" ::: "memory");
        }
    }
    __syncthreads();
}

constexpr int NPHASE = 27;

#ifndef DUP_MASK
#define DUP_MASK 0
#endif
#ifndef SAMPLE_REPS
#define SAMPLE_REPS 1
#endif
__global__ void __launch_bounds__(NTHR, 2) fwd_megakernel(Args args) {
    extern __shared__ __attribute__((aligned(16))) unsigned char lds[];
    cg::grid_group grid = cg::this_grid();
    const int G = gridDim.x, bx = blockIdx.x;
    const int lo = args.ph_lo, hi = args.ph_hi;
#define IN(i) ({ int _i = (i); asm volatile("" : "+s"(_i)); args.in[_i]; })

    unsigned* barw = (unsigned*)(args.ws + 16384);
    volatile LAS unsigned* MISC = (volatile LAS unsigned*)((LAS unsigned char*)lds + (LDS_BYTES - 64));
    if (threadIdx.x < 16) MISC[threadIdx.x] = 0u;
    if (bx == 0) { for (int i = threadIdx.x; i < XCD_BAR_WORDS; i += NTHR) __hip_atomic_store(barw + i, 0u, RLX_AGENT); }
    __syncthreads();
    unsigned xid = 0; bool xposted = false;

    for (int ph = lo; ph < hi; ++ph) {
        if (ph > lo) {
            unsigned* bw = (unsigned*)(args.ws + 16384); asm volatile("" : "+s"(bw));
            if (!xposted) { grid.sync(); const XcdBarrier t = xcd_barrier_post(bw, MISC + 8); xid = t.x; xposted = true; }
            else { XcdBarrier t; t.bar = bw; t.x = xid; t.st = MISC + 8; xcd_barrier(t); }
        }
        const int nrep = ((DUP_MASK >> (ph == 0 ? 0 : ((ph - 1) % 13) + 1)) & 1) ? 2 : 1;
        for (int rep = 0; rep < nrep; ++rep) {
        int tid = threadIdx.x; asm volatile("" : "+v"(tid));
        const int lane = tid & 63, wave = __builtin_amdgcn_readfirstlane(tid >> 6);
        const int gw = bx * NWAVES + wave, NGW = G * NWAVES;
        unsigned char* ws = args.ws; asm volatile("" : "+s"(ws));
        float* out = args.out; asm volatile("" : "+s"(out));
        PG8_LAS unsigned char* ldsl = (PG8_LAS unsigned char*)lds;
        float* X = (float*)(ws + WS_X); bf16* Xb = (bf16*)(ws + WS_XB); float* PRE = (float*)(ws + WS_PRE); bf16* P = (bf16*)(ws + WS_P);
        const int l = ph == 0 ? 0 : (ph - 1) / 13; const int k = ph == 0 ? -1 : (ph - 1) % 13;
        unsigned char* wb = ws + (l ? W1OFF : 0);
        if (ph == 0) {
            LayerW L{IN(9), IN(25), IN(28), IN(29), IN(30), IN(31), IN(34), IN(35), IN(36), IN(12), IN(14), IN(15)};
            if (G == 256) { for (int i2 = gw; i2 < CONV_NIT - 2816; i2 += NGW) convert_item(L, ws, (float*)lds + wave * 4160, i2 < 9376 ? i2 : i2 + 2816, lane); }
            else convert_weights(L, ws, (float*)lds + wave * 4160, gw, NGW, lane);
            for (int m = gw; m < MROWS; m += NGW) row_copy_cvt(m < NPR ? IN(0) + (size_t)m * DM : IN(2) + (size_t)(m - NPR) * DM, nullptr, Xb + (size_t)m * DM, lane);
            for (int m = gw; m < 1024; m += NGW) row_copy_cvt(IN(1) + (size_t)m * DM, nullptr, (bf16*)(ws + WS_MEMB) + (size_t)m * DM, lane);
            continue;
        }
        if (k == 6 && l == 0 && G == 256 && (bx >= 68 && (bx < 128 || bx >= 144))) {
            const int idx = bx < 128 ? bx - 68 : bx - 144 + 60;
            LayerW L{IN(9), IN(25), IN(28), IN(29), IN(30), IN(31), IN(34), IN(35), IN(36), IN(12), IN(14), IN(15)};
            for (int i2 = idx * NWAVES + wave; i2 < 2816; i2 += 172 * NWAVES) convert_item(L, ws, (float*)lds + wave * 4160, 9376 + i2, lane);
            continue;
        }
        if (k == 0 || k == 4 || k == 6 || k == 8 || k == 10 || k == 11) {
            const int nsub = (k == 0 || k == 10) ? 1 : 2;
            for (int sub = 0; sub < nsub; ++sub) {
                pg8::Gemm g; pg8::EpiGen E; int cshift = 0;
                E.mode = 0; E.O = PRE; E.ldc = DM; E.res = X; E.alpha = ALPHA; E.split_cols = 0; E.split_stride = 0; E.H = (bf16*)(ws + WS_H); E.ldh = FF; E.nkt = 0; E.kplane = 0;
                g.A = Xb; g.M = MROWS; g.N = DM; g.K = DM; g.Bt = (const bf16*)(wb + WS_WOUT);
                if (k == 0) { g.Bt = (const bf16*)(wb + WS_WIN); g.N = PLD; E.mode = 3; E.H = P; E.ldh = PLD; E.res = nullptr; }
                else if (k == 4) { g.A = (const bf16*)(ws + WS_MIX); if (l == 0) E.res = IN(0); }
                else if (k == 6 && sub == 0) { g.Bt = (const bf16*)(wb + WS_WQ); g.N = XAW; E.O = (float*)(ws + WS_Q); E.ldc = XAW; E.res = nullptr; }
                else if (k == 6) { g.A = (const bf16*)(ws + WS_MEMB); g.Bt = (const bf16*)(wb + WS_WKV); g.M = 1024; g.N = 1024; cshift = 128;
                    E.O = out + O_PMK + (size_t)l * 4 * 256 * 512; E.ldc = 512; E.res = nullptr; E.split_cols = 512; E.split_stride = (size_t)(O_PMV - O_PMK); }
                else if (k == 8) { g.A = (const bf16*)(ws + WS_AO); g.Bt = (const bf16*)(wb + WS_WO); g.K = XAW; }
                else if (k == 10) { g.Bt = (const bf16*)(wb + WS_WGU); g.N = 2 * FF; E.mode = 1; }
                else { g.A = (const bf16*)(ws + WS_H); g.Bt = (const bf16*)(wb + WS_WD); g.K = FF; }
                int nsplit = 1;
                if ((k == 4 || k == 8 || k == 11) && sub == 0) { g.M = NPR; E.mode = 4; E.H = (bf16*)PRE; E.ldh = DM; }
                if ((k == 4 || k == 8 || k == 11) && sub == 1) {
                    g.A += (size_t)NPR * g.K; g.M = NSM; nsplit = (k == 4) ? 8 : (k == 8) ? 4 : 11;
                    E.O = (float*)(ws + WS_PART); E.res = (k == 4 && l == 0) ? IN(2) : X + (size_t)NPR * DM; E.nkt = g.K / 64 / nsplit; E.kplane = (size_t)NSM * DM; }
                g.nt = g.K / 64 / nsplit;
                pg8::StaticOrder S; S.init(g.M, g.N, G, (bx + cshift) % G); S.nsplit = nsplit; S.nkt = g.nt;
                pg8::gemm_phase<pg8::EpiGen, pg8::StaticOrder, true, true>(ldsl, g, S, E);
                __syncthreads();
            }
            continue;
        }
        switch (k) {
        case 1: {
            PrepArgs a;
            a.P = P; a.state_shift = IN(4) + (size_t)l * 128 * RWC; a.state_conv = IN(6) + (size_t)l * 128 * 3 * 3072;
            a.mu = IN(10) + l * RWC; a.w0 = IN(11) + l * 1024; a.a0 = IN(13) + l * 1024; a.kkw = IN(16) + l * 1024; a.kaw = IN(17) + l * 1024;
            a.convw = IN(21) + l * 4 * 3072; a.alog = IN(22) + l * 8; a.dtb = IN(23) + l * 8;
            a.W2t = (const bf16*)(wb + WS_LORA); a.A2t = a.W2t + 65536; a.G2t = a.W2t + 131072;
            a.R = (float*)(ws + WS_R); a.W = (float*)(ws + WS_W); a.K = (float*)(ws + WS_K); a.V = (float*)(ws + WS_V); a.A = (float*)(ws + WS_A); a.B = (float*)(ws + WS_B); a.G = (float*)(ws + WS_G);
            a.QG = (float*)(ws + WS_QG); a.KG = (float*)(ws + WS_KG); a.VG = (float*)(ws + WS_VG); a.BETA = (float*)(ws + WS_BG); a.GDEC = a.BETA + MROWS * 8;
            a.o_psh = out + O_PSH + (size_t)l * 4 * RWC; a.o_pcv = out + O_PCV + (size_t)l * 4 * 3 * 3072; a.o_ssh = out + O_SSH + (size_t)l * 128 * RWC; a.o_scv = out + O_SCV + (size_t)l * 128 * 3 * 3072;
            const int vcu1 = (G % 8 == 0) ? (bx % 8) * (G / 8) + bx / 8 : bx;
            for (int u = vcu1; u < (MROWS / 32) * 4; u += G) prep_rw_unit(a, ldsl, u, tid, wave, lane);
            for (int q = gw; q < MROWS * 4; q += NGW) prep_gd_pair(a, q, lane);
            for (int u = gw; u < 528; u += NGW) prep_copy_unit(a, u, lane);
        } break;
        case 2: {
            ScanArgs a;
            a.R = (const float*)(ws + WS_R); a.W = (const float*)(ws + WS_W); a.K = (const float*)(ws + WS_K); a.V = (const float*)(ws + WS_V); a.A = (const float*)(ws + WS_A); a.B = (const float*)(ws + WS_B);
            a.QG = (const float*)(ws + WS_QG); a.KG = (const float*)(ws + WS_KG); a.VG = (const float*)(ws + WS_VG); a.BETA = (const float*)(ws + WS_BG); a.GDEC = a.BETA + MROWS * 8;
            a.st_rw = IN(3) + (size_t)l * 128 * 16 * 4096; a.st_gd = IN(5) + (size_t)l * 128 * 8 * 16384;
            a.ORW = (float*)(ws + WS_ORW); a.OGD = (float*)(ws + WS_OGD);
            a.o_prw = out + O_PRW + (size_t)l * 4 * 16 * 4096; a.o_pgd = out + O_PGD + (size_t)l * 4 * 8 * 16384;
            a.o_srw = out + O_SRW + (size_t)l * 128 * 16 * 4096; a.o_sgd = out + O_SGD + (size_t)l * 128 * 8 * 16384;
            const int vcu = (G % 8 == 0) ? (bx % 8) * (G / 8) + bx / 8 : bx;
            if (G == 256) {
                scan_prompt(a, ldsl, vcu, tid, wave, lane, vcu * 4 + (wave & 3), l == 0, args, ws + W1OFF);
            } else {
                for (int it = vcu; it < 256; it += G) scan_prompt(a, ldsl, it, tid, wave, lane, 0, false, args, nullptr);
                for (int srep = 0; srep < SAMPLE_REPS; ++srep)
                for (int u = vcu * NWAVES + wave; u < 32768; u += NGW) { if (u < 16384) scan_sample_rw<2>(a, u, lane); else scan_sample_gd<2>(a, u - 16384, lane); }
            }
        } break;
        case 3: {
            PostArgs a;
            a.P = P; a.R = (const float*)(ws + WS_R); a.K = (const float*)(ws + WS_K); a.V = (const float*)(ws + WS_V); a.G = (const float*)(ws + WS_G);
            a.ORW = (const float*)(ws + WS_ORW); a.OGD = (const float*)(ws + WS_OGD);
            a.rk = IN(18) + l * 1024; a.lnxw = IN(19) + l * 1024; a.lnxb = IN(20) + l * 1024; a.normw = IN(24) + l * 128; a.MIX = (bf16*)(ws + WS_MIX);
            for (int m = gw; m < MROWS; m += NGW) post_row(a, m, lane);
        } break;
        case 5: case 9: case 12: {
            const int gi = k == 5 ? 26 : k == 9 ? 32 : 37;
            const float* gg = IN(gi) + l * DM; const float* bb = IN(gi + 1) + l * DM;
            const bool fin = (k == 12 && l == 1);
            int m = gw;
            for (; m + NGW < NPR; m += 2 * NGW) {
                const int m2 = m + NGW;
                ln_row2((const bf16*)PRE + (size_t)m * DM, (const bf16*)PRE + (size_t)m2 * DM, gg, bb,
                        fin ? out + O_YP + (size_t)m * DM : X + (size_t)m * DM, fin ? out + O_YP + (size_t)m2 * DM : X + (size_t)m2 * DM,
                        fin ? nullptr : Xb + (size_t)m * DM, fin ? nullptr : Xb + (size_t)m2 * DM, lane);
            }
            for (; m < MROWS; m += NGW) {
                float* df = fin ? (m < NPR ? out + O_YP + (size_t)m * DM : out + O_YS + (size_t)(m - NPR) * DM) : X + (size_t)m * DM;
                const bool smp = m >= NPR;
                ln_row((const float*)(ws + WS_PART) + (size_t)(smp ? m - NPR : 0) * DM, smp ? nullptr : (const bf16*)PRE + (size_t)m * DM, smp ? (k == 5 ? 8 : k == 9 ? 4 : 11) : 1, gg, bb, df, fin ? nullptr : Xb + (size_t)m * DM, lane);
            }
            if (k == 12 && l == 0 && G != 256) {
                LayerW L{IN(9) + (size_t)DM * INC, IN(25) + (size_t)DM * DM, IN(28) + (size_t)DM * XAW, IN(29) + (size_t)DM * XAW, IN(30) + (size_t)DM * XAW,
                         IN(31) + (size_t)XAW * DM, IN(34) + (size_t)DM * FF, IN(35) + (size_t)DM * FF, IN(36) + (size_t)FF * DM,
                         IN(12) + 65536, IN(14) + 65536, IN(15) + 131072};
                convert_weights(L, ws + W1OFF, (float*)lds + wave * 4160, gw, NGW, lane);
            }
        } break;
        case 7: {
            const float* Q = (const float*)(ws + WS_Q); bf16* AO = (bf16*)(ws + WS_AO);
            const int vcu7 = (G % 8 == 0) ? (bx % 8) * (G / 8) + bx / 8 : bx;
            for (int u = vcu7; u < 256 + 512; u += G) {
                if (u < 256) { const int b = u >> 6, h = (u >> 4) & 3, qb = u & 15;
                    const size_t kvo = ((size_t)(l * 4 + b) * 256) * 512 + h * 128;
                    attn_unit(out + O_PMK + kvo, out + O_PMV + kvo, Q, AO, b * SEQ + qb * 128, 128, true, h * 128, lds, tid, wave, lane);
                } else { const int j = u - 256; const int b = j >> 2, h = j & 3;
                    const size_t kvo = ((size_t)(l * 128 + b) * 256) * 512 + h * 128;
                    attn_unit(IN(7) + kvo, IN(8) + kvo, Q, AO, NPR + b * 4, 4, false, h * 128, lds, tid, wave, lane);
                }
            }
        } break;
        default: break;
        }
        }
    }
}

#ifndef MK_PER_PHASE
#define MK_PER_PHASE 0
#endif
extern "C" void kernel_launch(void* const* d_in, const int* in_sizes, int n_in, void* d_out, int out_size, void* d_ws, size_t ws_size, hipStream_t stream) {
    static int grid = 0;
    if (grid == 0) {
        if (n_in != 39 || (size_t)out_size != O_END || ws_size < WS_END) { fprintf(stderr, "kernel_launch: unexpected sizes n_in %d out %d ws %zu (need %zu)\n", n_in, out_size, ws_size, (size_t)WS_END); }
        int dev = 0, cus = 0, per_cu = 0;
        hipGetDevice(&dev); hipDeviceGetAttribute(&cus, hipDeviceAttributeMultiprocessorCount, dev);
        hipFuncSetAttribute((const void*)fwd_megakernel, hipFuncAttributeMaxDynamicSharedMemorySize, LDS_BYTES);
        hipOccupancyMaxActiveBlocksPerMultiprocessor(&per_cu, (const void*)fwd_megakernel, NTHR, LDS_BYTES);
        if (per_cu < 1) { fprintf(stderr, "kernel_launch: occupancy query says %d\n", per_cu); per_cu = 1; }
        grid = cus * 1;
        if (cus <= 0) grid = 256;
    }
    Args a{};
    for (int i = 0; i < 39; ++i) a.in[i] = (const float*)d_in[i];
    a.out = (float*)d_out; a.ws = (unsigned char*)d_ws;
#if MK_PER_PHASE
    for (int p = 0; p < NPHASE; ++p) { a.ph_lo = p; a.ph_hi = p + 1; void* kargs[] = {&a};
        hipError_t e = hipLaunchCooperativeKernel((const void*)fwd_megakernel, dim3(grid), dim3(NTHR), kargs, LDS_BYTES, stream);
        if (e != hipSuccess) { fprintf(stderr, "launch %d failed: %s\n", p, hipGetErrorString(e)); break; } }
#else
    a.ph_lo = 0; a.ph_hi = NPHASE; void* kargs[] = {&a};
    hipError_t e = hipLaunchCooperativeKernel((const void*)fwd_megakernel, dim3(grid), dim3(NTHR), kargs, LDS_BYTES, stream);
    if (e != hipSuccess) fprintf(stderr, "cooperative launch failed: %s (grid %d)\n", hipGetErrorString(e), grid);
#endif
}
```

```cpp
#include <hip/hip_runtime.h>
#include <hip/hip_cooperative_groups.h>
#include <cstdio>
#include <cstdint>
namespace cg = cooperative_groups;
#define DUP_MASK 0
#define SAMPLE_REPS 1
namespace pg8 {
#define PG8_LAS __attribute__((address_space(3)))
typedef unsigned short bf16_t;
typedef short bf16x8 __attribute__((ext_vector_type(8)));
typedef float f32x4 __attribute__((ext_vector_type(4)));
typedef unsigned u32x4 __attribute__((ext_vector_type(4)));
constexpr int BM = 256, BK = 64, HALF = 128, HTB = HALF * BK * 2  , STAGE_BYTES = 8 * HTB, NXCD = 8, WGM = 8;

__host__ __device__ __forceinline__ int lds_byte(int r, int c) { const int st = (r >> 4) * 2 + (c >> 5), rr = r & 15, cc = c & 31, ob = rr * 64 + cc * 2; return st * 1024 + (ob ^ (((ob >> 9) & 1) << 5)); }
__host__ __device__ __forceinline__ void stage_rc(int b, int& R, int& C) { const int st = b / 1024, sb = b % 1024, swz = sb ^ (((sb >> 9) & 1) << 5); R = (st >> 1) * 16 + swz / 64; C = (st & 1) * 32 + (swz % 64) / 2; }
__host__ __device__ __forceinline__ int perm32(int rho) { const int n = rho >> 4, i = rho & 15; return 8 * (i >> 2) + 4 * n + (i & 3); }

struct Unit { int pm, pn, kt0; };
struct Gemm { const bf16_t* A; const bf16_t* Bt; int M, N, K, nt; };

struct StaticOrder {
    int nM, nN, nwg, G, c, nsplit, nkt;
    __host__ __device__ void init(int M, int N, int G_, int c_) { nM = M / BM; nN = N / BM; nwg = nM * nN; G = G_; c = c_; nsplit = 1; nkt = 0; }
    __host__ __device__ bool next(int i, Unit& u) const {
        const long L0 = (long)i * G + c; const long tot = (long)nwg * nsplit; const bool ok = L0 < tot; const int L = ok ? (int)L0 : 0;
        int pm, pn, kt0;
        if (nsplit > 1) { const int tile = L % nwg, sp = L / nwg; pm = tile / nN; pn = tile % nN; kt0 = sp * nkt; }
        else {
            int wgid = L; { const int q = nwg / NXCD, r = nwg % NXCD, xcd = wgid % NXCD, off = wgid / NXCD; wgid = (xcd < r ? xcd * (q + 1) : r * (q + 1) + (xcd - r) * q) + off; }
            const int nig = WGM * nN, gid = wgid / nig, fm = gid * WGM, gsz = (nM - fm) < WGM ? (nM - fm) : WGM;
            pm = fm + ((wgid % nig) % gsz); pn = (wgid % nig) / gsz; kt0 = 0;
        }
        u.pm = pm; u.pn = pn; u.kt0 = kt0; return ok;
    }
    __device__ __forceinline__ void a_ready(const Unit&) const {}
    __device__ __forceinline__ void done(const Unit&) const {}
};

__device__ __forceinline__ unsigned cvt_pk_bf16(float lo, float hi) { unsigned r; asm volatile("v_cvt_pk_bf16_f32 %0, %1, %2" : "=v"(r) : "v"(lo), "v"(hi)); return r; }
typedef float f32x2 __attribute__((ext_vector_type(2)));

#define PG8_GAS __attribute__((address_space(1)))
struct EpiF32 {
    static constexpr bool PERM = true, AFTER_DRAIN = false;
    float* O; int ldc; const float* res_; float alpha; int split_cols; size_t split_stride; int nkt; size_t kplane;
    __device__ __forceinline__ void operator()(const f32x4 (&acc)[2][2][4][2], const Unit& u, int wr, int wc, int fr, int fq) const {
        const int row0 = u.pm * BM + wr * 64 + fr; int colt = u.pn * BM; float* base = O; const float* res = res_;
        if (nkt) { const int sp = u.kt0 / nkt; base += (size_t)sp * kplane; if (sp) res = nullptr; }
        if (split_cols) { const int t = colt / split_cols; base += (size_t)t * split_stride; colt -= t * split_cols; }
        const int col0 = colt + wc * 32 + 8 * fq;
#pragma unroll
        for (int ai = 0; ai < 2; ++ai)
#pragma unroll
            for (int m = 0; m < 4; ++m) {
                const size_t ro = (size_t)(row0 + ai * HALF + m * 16) * ldc + col0;
#pragma unroll
                for (int bj = 0; bj < 2; ++bj) {
                    f32x4 v0 = acc[ai][bj][m][0], v1 = acc[ai][bj][m][1];
                    if (res) { const f32x4 r0 = *(const PG8_GAS f32x4*)(res + ro + bj * HALF), r1 = *(const PG8_GAS f32x4*)(res + ro + bj * HALF + 4); v0 += r0 * alpha; v1 += r1 * alpha; }
                    *(PG8_GAS f32x4*)(base + ro + bj * HALF) = v0; *(PG8_GAS f32x4*)(base + ro + bj * HALF + 4) = v1;
                }
            }
    }
};
struct EpiSwiGLU {
    static constexpr bool PERM = true, AFTER_DRAIN = false;
    bf16_t* H; int ldh;
    __device__ __forceinline__ void operator()(const f32x4 (&acc)[2][2][4][2], const Unit& u, int wr, int wc, int fr, int fq) const {
        const int row0 = u.pm * BM + wr * 64 + fr; const int hc0 = u.pn * 128 + wc * 16 + 4 * fq;
#pragma unroll
        for (int ai = 0; ai < 2; ++ai)
#pragma unroll
            for (int m = 0; m < 4; ++m) {
                bf16_t* rowp = H + (size_t)(row0 + ai * HALF + m * 16) * ldh + hc0;
#pragma unroll
                for (int bj = 0; bj < 2; ++bj) {
                    const f32x4 g = acc[ai][bj][m][0], up = acc[ai][bj][m][1]; float h[4];
#pragma unroll
                    for (int e = 0; e < 4; ++e) h[e] = g[e] * __builtin_amdgcn_rcpf(1.0f + __expf(-g[e])) * up[e];
                    typedef unsigned u32x2v __attribute__((ext_vector_type(2)));
                    u32x2v w; w.x = cvt_pk_bf16(h[0], h[1]); w.y = cvt_pk_bf16(h[2], h[3]);
                    *(PG8_GAS u32x2v*)(rowp + bj * 64) = w;
                }
            }
    }
};

struct EpiAtomic {
    float* O; int ldc;
    __device__ __forceinline__ void operator()(const f32x4 (&acc)[2][2][4][2], const Unit& u, int wr, int wc, int fr, int fq) const {
        const int row0 = u.pm * BM + wr * 64 + fr; const int col0 = u.pn * BM + wc * 32 + 8 * fq;
#pragma unroll
        for (int ai = 0; ai < 2; ++ai)
#pragma unroll
            for (int m = 0; m < 4; ++m) {
                PG8_GAS float* rp = (PG8_GAS float*)(O + (size_t)(row0 + ai * HALF + m * 16) * ldc + col0);
#pragma unroll
                for (int bj = 0; bj < 2; ++bj)
#pragma unroll
                    for (int n = 0; n < 2; ++n)
#pragma unroll
                        for (int e = 0; e < 4; ++e) __hip_atomic_fetch_add(rp + bj * HALF + 4 * n + e, acc[ai][bj][m][n][e], __ATOMIC_RELAXED, __HIP_MEMORY_SCOPE_AGENT);
            }
    }
};
struct EpiBf16 {
    bf16_t* O; int ld;
    __device__ __forceinline__ void operator()(const f32x4 (&acc)[2][2][4][2], const Unit& u, int wr, int wc, int fr, int fq) const {
        const int row0 = u.pm * BM + wr * 64 + fr; const int col0 = u.pn * BM + wc * 32 + 8 * fq;
#pragma unroll
        for (int ai = 0; ai < 2; ++ai)
#pragma unroll
            for (int m = 0; m < 4; ++m) {
                bf16_t* rowp = O + (size_t)(row0 + ai * HALF + m * 16) * ld + col0;
#pragma unroll
                for (int bj = 0; bj < 2; ++bj) { const f32x4 v0 = acc[ai][bj][m][0], v1 = acc[ai][bj][m][1];
                    u32x4 w; w.x = cvt_pk_bf16(v0[0], v0[1]); w.y = cvt_pk_bf16(v0[2], v0[3]); w.z = cvt_pk_bf16(v1[0], v1[1]); w.w = cvt_pk_bf16(v1[2], v1[3]);
                    *(PG8_GAS u32x4*)(rowp + bj * HALF) = w; }
            }
    }
};
struct EpiBf16Res {
    bf16_t* O; int ld; const float* res; float alpha;
    __device__ __forceinline__ void operator()(const f32x4 (&acc)[2][2][4][2], const Unit& u, int wr, int wc, int fr, int fq) const {
        const int row0 = u.pm * BM + wr * 64 + fr; const int col0 = u.pn * BM + wc * 32 + 8 * fq;
#pragma unroll
        for (int ai = 0; ai < 2; ++ai)
#pragma unroll
            for (int m = 0; m < 4; ++m) {
                const size_t ro = (size_t)(row0 + ai * HALF + m * 16) * ld + col0;
#pragma unroll
                for (int bj = 0; bj < 2; ++bj) {
                    const f32x4 r0 = *(const PG8_GAS f32x4*)(res + ro + bj * HALF), r1 = *(const PG8_GAS f32x4*)(res + ro + bj * HALF + 4);
                    const f32x4 v0 = acc[ai][bj][m][0] + r0 * alpha, v1 = acc[ai][bj][m][1] + r1 * alpha;
                    u32x4 w; w.x = cvt_pk_bf16(v0[0], v0[1]); w.y = cvt_pk_bf16(v0[2], v0[3]); w.z = cvt_pk_bf16(v1[0], v1[1]); w.w = cvt_pk_bf16(v1[2], v1[3]);
                    *(PG8_GAS u32x4*)(O + ro + bj * HALF) = w; }
            }
    }
};
struct EpiGen {
    static constexpr bool PERM = true, AFTER_DRAIN = false;
    int mode; float* O; int ldc; const float* res; float alpha; int split_cols; size_t split_stride; bf16_t* H; int ldh; int nkt; size_t kplane;
    __device__ __forceinline__ void operator()(const f32x4 (&acc)[2][2][4][2], const Unit& u, int wr, int wc, int fr, int fq) const {
        if (mode == 0) { EpiF32 e{O, ldc, res, alpha, split_cols, split_stride, nkt, kplane}; e(acc, u, wr, wc, fr, fq); }
        else if (mode == 1) { EpiSwiGLU e{H, ldh}; e(acc, u, wr, wc, fr, fq); }
        else if (mode == 3) { EpiBf16 e{H, ldh}; e(acc, u, wr, wc, fr, fq); }
        else if (mode == 4) { EpiBf16Res e{H, ldh, res, alpha}; e(acc, u, wr, wc, fr, fq); }
        else { EpiAtomic e{O, ldc}; e(acc, u, wr, wc, fr, fq); }
    }
};
template <class Epi, class Sched, bool ALIGN_EPI = false, bool SP2 = false>
__device__ __forceinline__ void gemm_phase(PG8_LAS unsigned char* lds, const Gemm g, const Sched& S, const Epi& E) {
    int tid_ = threadIdx.x; asm volatile("" : "+v"(tid_));
    const int tid = tid_, wid = __builtin_amdgcn_readfirstlane(tid >> 6), lane = tid & 63, wr = wid >> 2, wc = wid & 3, fr = lane & 15, fq = lane >> 4;
    const int K = g.K, nt = g.nt;
    unsigned voffA[2], voffB[2];
#pragma unroll
    for (int i = 0; i < 2; ++i) { int R, C; stage_rc(tid * 16 + i * 8192, R, C); const int Rb = Epi::PERM ? ((R & ~31) + perm32(R & 31)) : R;
        voffA[i] = (unsigned)(R * K + C) * 2u; voffB[i] = (unsigned)(Rb * K + C) * 2u; }
    const size_t kstep = (size_t)(BK * 2);
    const size_t hstep = (size_t)HALF * K * 2;
    const size_t tstep = 2 * hstep;
    const unsigned ldsw = (unsigned)wid * 1024u;
    const int aoff = lds_byte(wr * 64 + fr, fq * 8), boff = lds_byte(wc * 32 + fr, fq * 8);
#define PG8_SA(b, h) (((b) * 2 + (h)) * HTB)
#define PG8_SB(b, h) ((4 + (b) * 2 + (h)) * HTB)
#define PG8_STAGE(bufoff, gbase, voff) do { _Pragma("unroll") for (int _i = 0; _i < 2; ++_i) \
        __builtin_amdgcn_global_load_lds((const unsigned*)((const char*)(gbase) + (voff)[_i]), (PG8_LAS unsigned*)(lds + (bufoff) + ldsw + _i * 8192), 16, 0, 0); } while (0)
#define PG8_LDA(dst, b, h) do { _Pragma("unroll") for (int m = 0; m < 4; ++m) _Pragma("unroll") for (int k = 0; k < 2; ++k) dst[m][k] = *(const PG8_LAS bf16x8*)(lds + PG8_SA(b, h) + aoff + m * 2048 + k * 1024); } while (0)
#define PG8_LDB(dst, b, h) do { _Pragma("unroll") for (int n = 0; n < 2; ++n) _Pragma("unroll") for (int k = 0; k < 2; ++k) dst[n][k] = *(const PG8_LAS bf16x8*)(lds + PG8_SB(b, h) + boff + n * 2048 + k * 1024); } while (0)
#define PG8_MMA(ai, bj, At, Bt) do { __builtin_amdgcn_s_setprio(1); _Pragma("unroll") for (int m = 0; m < 4; ++m) _Pragma("unroll") for (int n = 0; n < 2; ++n) _Pragma("unroll") for (int k = 0; k < 2; ++k) \
        acc[ai][bj][m][n] = __builtin_amdgcn_mfma_f32_16x16x32_bf16(Bt[n][k], At[m][k], acc[ai][bj][m][n], 0, 0, 0); __builtin_amdgcn_s_setprio(0); } while (0)
#define PG8_WAIT_V(n) asm volatile("s_waitcnt vmcnt(" #n ")" ::: "memory")
#define PG8_WAIT_L(n) asm volatile("s_waitcnt lgkmcnt(" #n ")" ::: "memory")
#define PG8_BAR __builtin_amdgcn_s_barrier()
#define PG8_SCHED __builtin_amdgcn_sched_barrier(0)
    Unit cur, nxt; int ui = 0;
    if (!S.next(0, cur)) return;
    f32x4 acc[2][2][4][2];
#pragma unroll
    for (int a = 0; a < 2; ++a)
#pragma unroll
        for (int b = 0; b < 2; ++b)
#pragma unroll
            for (int m = 0; m < 4; ++m)
#pragma unroll
                for (int n = 0; n < 2; ++n) acc[a][b][m][n] = (f32x4){0.f, 0.f, 0.f, 0.f};
    bf16x8 At[4][2], B0[2][2], B1[2][2];
    const char* cA = (const char*)g.A + (size_t)cur.pm * tstep + (size_t)cur.kt0 * kstep; const char* cB = (const char*)g.Bt + (size_t)cur.pn * tstep + (size_t)cur.kt0 * kstep;
    S.a_ready(cur);
    if constexpr (SP2) {
        PG8_STAGE(PG8_SB(0, 0), cB, voffB); PG8_STAGE(PG8_SB(0, 1), cB + hstep, voffB); PG8_STAGE(PG8_SA(0, 0), cA, voffA); PG8_STAGE(PG8_SA(0, 1), cA + hstep, voffA);
        if (wr == 1) PG8_BAR;
        PG8_WAIT_V(2); PG8_BAR;
        PG8_STAGE(PG8_SB(1, 0), cB + kstep, voffB); PG8_STAGE(PG8_SA(1, 0), cA + kstep, voffA); PG8_STAGE(PG8_SB(1, 1), cB + hstep + kstep, voffB);
        PG8_WAIT_V(6); PG8_BAR;
    } else {
        PG8_STAGE(PG8_SB(0, 0), cB, voffB); PG8_STAGE(PG8_SA(0, 0), cA, voffA); PG8_STAGE(PG8_SB(0, 1), cB + hstep, voffB); PG8_STAGE(PG8_SA(0, 1), cA + hstep, voffA);
        if (wr == 1) PG8_BAR;
        PG8_WAIT_V(4); PG8_BAR;
        PG8_STAGE(PG8_SB(1, 0), cB + kstep, voffB); PG8_STAGE(PG8_SA(1, 0), cA + kstep, voffA); PG8_STAGE(PG8_SB(1, 1), cB + hstep + kstep, voffB);
        PG8_WAIT_V(6); PG8_BAR;
    }
    for (;;) {
        const bool has_next = S.next(ui + 1, nxt);
        const char* nA = has_next ? (const char*)g.A + (size_t)nxt.pm * tstep + (size_t)nxt.kt0 * kstep : cA; const char* nB = has_next ? (const char*)g.Bt + (size_t)nxt.pn * tstep + (size_t)nxt.kt0 * kstep : cB;
        for (int t = 0; t < nt; t += 2) {
            const bool last = (t == nt - 2);
            const char* a1 = cA + (size_t)(t + 1) * kstep;
            const char* a2 = last ? nA : cA + (size_t)(t + 2) * kstep; const char* b2 = last ? nB : cB + (size_t)(t + 2) * kstep;
            const char* a3 = a2 + kstep; const char* b3 = b2 + kstep;
            if (last && has_next) S.a_ready(nxt);
            if constexpr (SP2) {
            PG8_LDB(B0, 0, 0); PG8_LDB(B1, 0, 1); PG8_SCHED; PG8_LDA(At, 0, 0); PG8_STAGE(PG8_SA(1, 1), a1 + hstep, voffA);
            PG8_WAIT_V(8); PG8_WAIT_L(0); PG8_BAR; PG8_MMA(0, 0, At, B0); PG8_MMA(0, 1, At, B1); PG8_BAR; PG8_SCHED;
            PG8_LDA(At, 0, 1); PG8_STAGE(PG8_SB(0, 0), b2, voffB); PG8_STAGE(PG8_SB(0, 1), b2 + hstep, voffB); PG8_STAGE(PG8_SA(0, 0), a2, voffA);
            PG8_WAIT_V(8); PG8_WAIT_L(0); PG8_BAR; PG8_MMA(1, 0, At, B0); PG8_MMA(1, 1, At, B1); PG8_BAR; PG8_SCHED;
            PG8_LDB(B0, 1, 0); PG8_LDB(B1, 1, 1); PG8_SCHED; PG8_LDA(At, 1, 0); PG8_STAGE(PG8_SA(0, 1), a2 + hstep, voffA);
            PG8_WAIT_V(8); PG8_WAIT_L(0); PG8_BAR; PG8_MMA(0, 0, At, B0); PG8_MMA(0, 1, At, B1); PG8_BAR; PG8_SCHED;
            PG8_LDA(At, 1, 1); PG8_STAGE(PG8_SB(1, 0), b3, voffB); PG8_STAGE(PG8_SB(1, 1), b3 + hstep, voffB); PG8_STAGE(PG8_SA(1, 0), a3, voffA);
            PG8_WAIT_V(8); PG8_WAIT_L(0); PG8_BAR; PG8_MMA(1, 0, At, B0); PG8_MMA(1, 1, At, B1); PG8_BAR; PG8_SCHED;
            } else {
            PG8_LDB(B0, 0, 0); PG8_SCHED; PG8_LDA(At, 0, 0); PG8_STAGE(PG8_SA(1, 1), a1 + hstep, voffA);
            PG8_WAIT_L(8); PG8_BAR; PG8_WAIT_L(0); PG8_MMA(0, 0, At, B0); PG8_BAR; PG8_SCHED;
            PG8_LDB(B1, 0, 1); PG8_STAGE(PG8_SB(0, 0), b2, voffB);
            PG8_BAR; PG8_WAIT_L(0); PG8_MMA(0, 1, At, B1); PG8_BAR;
            PG8_LDA(At, 0, 1); PG8_STAGE(PG8_SA(0, 0), a2, voffA);
            PG8_BAR; PG8_WAIT_L(0); PG8_MMA(1, 0, At, B0); PG8_BAR; PG8_SCHED;
            PG8_STAGE(PG8_SB(0, 1), b2 + hstep, voffB);
            PG8_WAIT_V(6); PG8_BAR; PG8_MMA(1, 1, At, B1); PG8_BAR;
            PG8_LDB(B0, 1, 0); PG8_SCHED; PG8_LDA(At, 1, 0); PG8_STAGE(PG8_SA(0, 1), a2 + hstep, voffA);
            PG8_WAIT_L(8); PG8_BAR; PG8_WAIT_L(0); PG8_MMA(0, 0, At, B0); PG8_BAR; PG8_SCHED;
            PG8_LDB(B1, 1, 1); PG8_STAGE(PG8_SB(1, 0), b3, voffB);
            PG8_BAR; PG8_WAIT_L(0); PG8_MMA(0, 1, At, B1); PG8_BAR;
            PG8_LDA(At, 1, 1); PG8_STAGE(PG8_SA(1, 0), a3, voffA);
            PG8_BAR; PG8_WAIT_L(0); PG8_MMA(1, 0, At, B0); PG8_BAR; PG8_SCHED;
            PG8_STAGE(PG8_SB(1, 1), b3 + hstep, voffB);
            PG8_WAIT_V(6); PG8_BAR; PG8_MMA(1, 1, At, B1); PG8_BAR;
            }
        }
        if constexpr (ALIGN_EPI) { if (wr == 0) PG8_BAR; }
        if constexpr (!Epi::AFTER_DRAIN) { E(acc, cur, wr, wc, fr, fq); S.done(cur); }
        if (!has_next) break;
#pragma unroll
        for (int a = 0; a < 2; ++a)
#pragma unroll
            for (int b = 0; b < 2; ++b)
#pragma unroll
                for (int m = 0; m < 4; ++m)
#pragma unroll
                    for (int n = 0; n < 2; ++n) acc[a][b][m][n] = (f32x4){0.f, 0.f, 0.f, 0.f};
        cur = nxt; cA = nA; cB = nB; ++ui;
        if constexpr (ALIGN_EPI) { if (wr == 1) PG8_BAR; }
    }
    PG8_WAIT_V(0);
    if constexpr (!ALIGN_EPI) { if (wr == 0) PG8_BAR; }
    PG8_BAR;
    if constexpr (Epi::AFTER_DRAIN) { E.fused(acc, cur, wr, wc, fr, fq, lds, wid, lane); S.done(cur); }
#undef PG8_SA
#undef PG8_SB
#undef PG8_STAGE
#undef PG8_LDA
#undef PG8_LDB
#undef PG8_MMA
#undef PG8_WAIT_V
#undef PG8_WAIT_L
#undef PG8_BAR
#undef PG8_SCHED
}
}

typedef unsigned short bf16;
typedef float f32x4 __attribute__((ext_vector_type(4)));
typedef float f32x2 __attribute__((ext_vector_type(2)));
typedef short bf16x8 __attribute__((ext_vector_type(8)));
typedef unsigned u32x4 __attribute__((ext_vector_type(4)));
typedef unsigned u32x2 __attribute__((ext_vector_type(2)));

constexpr int NWAVES = 8, NTHR = 512;
constexpr int DM = 2048, NPR = 8192, NSM = 512, MROWS = 8704, SEQ = 2048;
constexpr int RWC = 3328, INC = 7440, PLD = 7680, GD0 = 3328;
constexpr int FF = 5632, XAW = 512;
constexpr float ALPHA = 1.41421356237f;
constexpr int LDS_BYTES = 147456;

constexpr size_t O_YP = 0, O_YS = O_YP + (size_t)NPR * DM, O_PRW = O_YS + (size_t)NSM * DM, O_PSH = O_PRW + 2ull * 4 * 16 * 4096,
    O_PGD = O_PSH + 2ull * 4 * RWC, O_PCV = O_PGD + 2ull * 4 * 8 * 16384, O_PMK = O_PCV + 2ull * 4 * 3 * 3072, O_PMV = O_PMK + 2ull * 4 * 256 * 512,
    O_SRW = O_PMV + 2ull * 4 * 256 * 512, O_SSH = O_SRW + 2ull * 128 * 16 * 4096, O_SGD = O_SSH + 2ull * 128 * RWC, O_SCV = O_SGD + 2ull * 128 * 8 * 16384,
    O_END = O_SCV + 2ull * 128 * 3 * 3072;
static_assert(O_END == 75139072ull, "output size");

constexpr size_t MiB = 1u << 20;
constexpr size_t WS_WIN = 1 * MiB, WS_WOUT = WS_WIN + 30 * MiB, WS_WQ = WS_WOUT + 8 * MiB, WS_WKV = WS_WQ + 2 * MiB, WS_WO = WS_WKV + 4 * MiB,
    WS_WGU = WS_WO + 2 * MiB, WS_WD = WS_WGU + 44 * MiB, WS_LORA = WS_WD + 22 * MiB, WS_X = WS_LORA + 1 * MiB, WS_XB = WS_X + 68 * MiB, WS_MEMB = WS_XB + 34 * MiB,
    WS_P = WS_MEMB + 4 * MiB, WS_SC = WS_P + 255 * MiB, WS_END = WS_SC + 442 * MiB;
constexpr size_t WS_PRE = WS_P;
constexpr size_t W1OFF = WS_P + 128 * MiB - WS_WIN;
static_assert(W1OFF + WS_X <= WS_SC, "second weight set inside the P region");
constexpr size_t SCB = 34 * MiB;
constexpr unsigned SCBF = (unsigned)(SCB / 4);
constexpr size_t WS_R = WS_SC, WS_W = WS_R + SCB, WS_K = WS_W + SCB, WS_V = WS_K + SCB, WS_A = WS_V + SCB, WS_B = WS_A + SCB, WS_G = WS_B + SCB,
    WS_QG = WS_G + SCB, WS_KG = WS_QG + SCB, WS_VG = WS_KG + SCB, WS_BG = WS_VG + SCB, WS_ORW = WS_BG + SCB, WS_OGD = WS_ORW + SCB;
static_assert(WS_OGD + SCB <= WS_END, "scan region");
constexpr size_t WS_MIX = WS_W;
constexpr size_t WS_H = WS_A, WS_Q = WS_QG, WS_AO = WS_KG, WS_PART = WS_VG;
static_assert(94 * MiB <= 3 * SCB && 44 * MiB <= 2 * SCB, "overlays");

__device__ __forceinline__ unsigned f2bf(float f) { unsigned u = __builtin_bit_cast(unsigned, f); return (u + 0x7fffu + ((u >> 16) & 1u)) >> 16; }
__device__ __forceinline__ unsigned pk2(float lo, float hi) { return f2bf(lo) | (f2bf(hi) << 16); }
template <int CTRL> __device__ __forceinline__ float dppf(float x) { return __builtin_bit_cast(float, __builtin_amdgcn_mov_dpp(__builtin_bit_cast(int, x), CTRL, 0xf, 0xf, true)); }
__device__ __forceinline__ float reduce16(float v) {
    v += dppf<0xB1>(v); v += dppf<0x4E>(v); v += dppf<0x141>(v); v += dppf<0x128>(v); return v;
}
__device__ __forceinline__ float reduce8(float v) {
    v += dppf<0xB1>(v); v += dppf<0x4E>(v); v += dppf<0x141>(v); return v;
}
__device__ __forceinline__ float wave_sum(float v) {
    v = reduce16(v); const int iv = __builtin_bit_cast(int, v);
    return (__builtin_bit_cast(float, __builtin_amdgcn_readlane(iv, 0)) + __builtin_bit_cast(float, __builtin_amdgcn_readlane(iv, 16))) +
           (__builtin_bit_cast(float, __builtin_amdgcn_readlane(iv, 32)) + __builtin_bit_cast(float, __builtin_amdgcn_readlane(iv, 48)));
}
#define GAS __attribute__((address_space(1)))
#define LAS __attribute__((address_space(3)))
__device__ __forceinline__ f32x4 ldg4(const float* p) { return *(const GAS f32x4*)p; }
__device__ __forceinline__ float ldg1(const float* p) { return *(const GAS float*)p; }
__device__ __forceinline__ void stg4(float* p, f32x4 v) { *(GAS f32x4*)p = v; }
__device__ __forceinline__ void stg1(float* p, float v) { *(GAS float*)p = v; }
__device__ __forceinline__ void stgb(bf16* p, unsigned v) { *(GAS bf16*)p = (bf16)v; }
__device__ __forceinline__ f32x2 lo2(f32x4 a) { return (f32x2){a.x, a.y}; }
__device__ __forceinline__ f32x2 hi2(f32x4 a) { return (f32x2){a.z, a.w}; }
__device__ __forceinline__ f32x4 ldb4(const bf16* p) { const u32x2 w = *(const GAS u32x2*)p;
    return (f32x4){__builtin_bit_cast(float, w.x << 16), __builtin_bit_cast(float, w.x & 0xffff0000u), __builtin_bit_cast(float, w.y << 16), __builtin_bit_cast(float, w.y & 0xffff0000u)}; }
__device__ __forceinline__ float ldb1(const bf16* p) { return __builtin_bit_cast(float, (unsigned)(*(const GAS bf16*)p) << 16); }
__device__ __forceinline__ float dot4(f32x4 a, f32x4 b) { f32x2 p = lo2(a) * lo2(b); p = __builtin_elementwise_fma(hi2(a), hi2(b), p); return p.x + p.y; }
__device__ __forceinline__ float dot8(f32x4 a0, f32x4 a1, f32x4 b0, f32x4 b1) {
    f32x2 p = lo2(a0) * lo2(b0), q = hi2(a0) * hi2(b0); p = __builtin_elementwise_fma(lo2(a1), lo2(b1), p); q = __builtin_elementwise_fma(hi2(a1), hi2(b1), q); p = p + q; return p.x + p.y; }
__device__ __forceinline__ float rcpf_(float x) { return __builtin_amdgcn_rcpf(x); }
__device__ __forceinline__ float rsqf_(float x) { return __builtin_amdgcn_rsqf(x); }
__device__ __forceinline__ float sigmoidf_(float x) { return rcpf_(1.0f + __expf(-x)); }
__device__ __forceinline__ float softplusf_(float x) { return fmaxf(x, 0.f) + __logf(1.0f + __expf(-fabsf(x))); }
__device__ __forceinline__ float tanhf_(float x) { return 1.0f - 2.0f * rcpf_(1.0f + __expf(2.0f * x)); }
#define LDS_WAIT() asm volatile("s_waitcnt lgkmcnt(0)" ::: "memory")

__device__ __forceinline__ void tr_item(const float* __restrict__ W, int K, int N, bf16* __restrict__ WT, int mode, int row_off, float* scr, int item, int lane) {
    const int nblk = (N + 63) >> 6; const int kb = item / nblk, nb = item - kb * nblk; const int k0 = kb * 64, n0 = nb * 64;
    const int kr = lane >> 4, nc = (lane & 15) * 4; const bool nv = n0 + nc < N;
    f32x4 v[16];
#pragma unroll
    for (int j = 0; j < 16; ++j) v[j] = nv ? ldg4(W + (size_t)(k0 + kr + 4 * j) * N + n0 + nc) : (f32x4){0.f, 0.f, 0.f, 0.f};
#pragma unroll
    for (int j = 0; j < 16; ++j) { float* d = scr + (kr + 4 * j) * 65 + nc; d[0] = v[j].x; d[1] = v[j].y; d[2] = v[j].z; d[3] = v[j].w; }
    LDS_WAIT();
    const int c = lane & 7;
#pragma unroll
    for (int j = 0; j < 8; ++j) {
        const int nn = (lane >> 3) + 8 * j; const float* s = scr + (8 * c) * 65 + nn;
        u32x4 o; o.x = pk2(s[0], s[65]); o.y = pk2(s[2 * 65], s[3 * 65]); o.z = pk2(s[4 * 65], s[5 * 65]); o.w = pk2(s[6 * 65], s[7 * 65]);
        const int ng = n0 + nn;
        if (ng < N) {
            const int drow = mode == 0 ? row_off + ng : ((ng >> 2) * 8 + (mode == 2 ? 4 : 0) + (ng & 3));
            *(GAS u32x4*)(WT + (size_t)drow * K + k0 + 8 * c) = o;
        }
    }
    LDS_WAIT();
}

struct Args { const float* in[39]; float* out; unsigned char* ws; int ph_lo, ph_hi; };
struct LayerW {
    const float *w_in, *w_out, *wq, *wk, *wv, *wo, *wg, *wu, *wd, *w2, *a2, *g2;
};
constexpr int CONV_NIT = 32 * 117 + 32 * 32 + 3 * (32 * 8) + 8 * 32 + 2 * (32 * 88) + 88 * 32 + 2 * 16 + 32;
__device__ __forceinline__ void convert_item(const LayerW& L, unsigned char* ws, float* scr, int it, int lane) {
    constexpr int I_IN = 32 * 117, I_OUT = 32 * 32, I_Q = 32 * 8, I_O = 8 * 32, I_G = 32 * 88, I_D = 88 * 32, I_L = 16;
    bf16* lora = (bf16*)(ws + WS_LORA);
    int r = it;
    if (r < I_IN) { tr_item(L.w_in, DM, INC, (bf16*)(ws + WS_WIN), 0, 0, scr, r, lane); return; } r -= I_IN;
    if (r < I_G) { tr_item(L.wg, DM, FF, (bf16*)(ws + WS_WGU), 1, 0, scr, r, lane); return; } r -= I_G;
    if (r < I_G) { tr_item(L.wu, DM, FF, (bf16*)(ws + WS_WGU), 2, 0, scr, r, lane); return; } r -= I_G;
    if (r < I_D) { tr_item(L.wd, FF, DM, (bf16*)(ws + WS_WD), 0, 0, scr, r, lane); return; } r -= I_D;
    if (r < I_OUT) { tr_item(L.w_out, DM, DM, (bf16*)(ws + WS_WOUT), 0, 0, scr, r, lane); return; } r -= I_OUT;
    if (r < I_Q) { tr_item(L.wq, DM, XAW, (bf16*)(ws + WS_WQ), 0, 0, scr, r, lane); return; } r -= I_Q;
    if (r < I_Q) { tr_item(L.wk, DM, XAW, (bf16*)(ws + WS_WKV), 0, 0, scr, r, lane); return; } r -= I_Q;
    if (r < I_Q) { tr_item(L.wv, DM, XAW, (bf16*)(ws + WS_WKV), 0, 512, scr, r, lane); return; } r -= I_Q;
    if (r < I_O) { tr_item(L.wo, XAW, DM, (bf16*)(ws + WS_WO), 0, 0, scr, r, lane); return; } r -= I_O;
    if (r < I_L) { tr_item(L.w2, 64, 1024, lora, 0, 0, scr, r, lane); return; } r -= I_L;
    if (r < I_L) { tr_item(L.a2, 64, 1024, lora + 65536, 0, 0, scr, r, lane); return; } r -= I_L;
    tr_item(L.g2, 128, 1024, lora + 131072, 0, 0, scr, r, lane);
}
__device__ __forceinline__ void convert_weights(const LayerW& L, unsigned char* ws, float* scr, int gw, int NGW, int lane) {
    for (int it = gw; it < CONV_NIT; it += NGW) convert_item(L, ws, scr, it, lane);
}
__device__ __forceinline__ void row_copy_cvt(const float* src, float* dstf, bf16* dstb, int lane) {
#pragma unroll
    for (int j = 0; j < 8; ++j) {
        const f32x4 v = ldg4(src + 4 * (lane + 64 * j));
        if (dstf) stg4(dstf + 4 * (lane + 64 * j), v);
        u32x2 w; w.x = pk2(v.x, v.y); w.y = pk2(v.z, v.w);
        *((GAS u32x2*)dstb + lane + 64 * j) = w;
    }
}
__device__ __forceinline__ void ln_row(const float* src, const bf16* srcb, int nparts, const float* g, const float* b, float* dstf, bf16* dstb, int lane) {
    f32x4 v[8]; float s = 0.f;
#pragma unroll
    for (int j = 0; j < 8; ++j) v[j] = srcb ? ldb4(srcb + 4 * (lane + 64 * j)) : ldg4(src + 4 * (lane + 64 * j));
    for (int p = 1; p < nparts; ++p) {
#pragma unroll
        for (int j = 0; j < 8; ++j) v[j] += ldg4(src + (size_t)p * (NSM * DM) + 4 * (lane + 64 * j));
    }
#pragma unroll
    for (int j = 0; j < 8; ++j) s += (v[j].x + v[j].y) + (v[j].z + v[j].w);
    const float mean = wave_sum(s) * (1.f / DM); float s2 = 0.f;
#pragma unroll
    for (int j = 0; j < 8; ++j) { v[j] = v[j] - mean; s2 += (v[j].x * v[j].x + v[j].y * v[j].y) + (v[j].z * v[j].z + v[j].w * v[j].w); }
    const float rstd = rsqf_(wave_sum(s2) * (1.f / DM) + 1e-5f);
#pragma unroll
    for (int j = 0; j < 8; ++j) {
        const f32x4 gg = ldg4(g + 4 * (lane + 64 * j)), bb = ldg4(b + 4 * (lane + 64 * j));
        const f32x4 y = v[j] * rstd * gg + bb;
        stg4(dstf + 4 * (lane + 64 * j), y);
        if (dstb) { u32x2 w; w.x = pk2(y.x, y.y); w.y = pk2(y.z, y.w); *((GAS u32x2*)dstb + lane + 64 * j) = w; }
    }
}

template <int NR> __device__ __forceinline__ void ln_rows_n(const bf16* src, size_t rstride, const float* g, const float* b, float* dst, bf16* xb, int lane) {
    f32x4 v[NR][8]; float sm[NR], rs[NR];
#pragma unroll
    for (int r = 0; r < NR; ++r)
#pragma unroll
        for (int j = 0; j < 8; ++j) v[r][j] = ldb4(src + r * rstride + 4 * (lane + 64 * j));
#pragma unroll
    for (int r = 0; r < NR; ++r) { float s0 = 0.f;
#pragma unroll
        for (int j = 0; j < 8; ++j) s0 += (v[r][j].x + v[r][j].y) + (v[r][j].z + v[r][j].w);
        sm[r] = wave_sum(s0) * (1.f / DM); }
#pragma unroll
    for (int r = 0; r < NR; ++r) { float q0 = 0.f;
#pragma unroll
        for (int j = 0; j < 8; ++j) { v[r][j] = v[r][j] - sm[r]; q0 += dot4(v[r][j], v[r][j]); }
        rs[r] = rsqf_(wave_sum(q0) * (1.f / DM) + 1e-5f); }
#pragma unroll
    for (int j = 0; j < 8; ++j) {
        const f32x4 gg = ldg4(g + 4 * (lane + 64 * j)), bb = ldg4(b + 4 * (lane + 64 * j));
#pragma unroll
        for (int r = 0; r < NR; ++r) {
            const f32x4 y = v[r][j] * rs[r] * gg + bb;
            stg4(dst + r * rstride + 4 * (lane + 64 * j), y);
            if (xb) { u32x2 w; w.x = pk2(y.x, y.y); w.y = pk2(y.z, y.w); *((GAS u32x2*)(xb + r * rstride) + lane + 64 * j) = w; }
        }
    }
}

struct PrepArgs {
    const bf16* P; const float* state_shift; const float* state_conv;
    const float *mu, *w0, *a0, *kkw, *kaw, *convw, *alog, *dtb;
    const bf16 *W2t, *A2t, *G2t;
    float *R, *W, *K, *V, *A, *B, *G, *QG, *KG, *VG, *BETA, *GDEC;
    float *o_psh, *o_pcv, *o_ssh, *o_scv;
};
__device__ __forceinline__ void prep_rw_unit(const PrepArgs& a, LAS unsigned char* lds, int unit, int tid, int wave, int lane) {
    LAS bf16* A2 = (LAS bf16*)lds;
    LAS float* LL = (LAS float*)(lds + 32 * 264 * 2);
    const int item = unit >> 2, hq = unit & 3; const int m0 = item * 32;
    const int quad = lane >> 4, l15 = lane & 15;
    {
        const int tk = tid >> 4, c0 = (tid & 15) * 16; const int m = m0 + tk;
        const bf16* prow = a.P + (size_t)m * PLD + 3072 + c0;
        const bf16* pprev = prow - PLD; const float* sprev = nullptr; float pm = 1.f;
        if (m < NPR) { if (!(m & (SEQ - 1))) { pprev = prow; pm = 0.f; } }
        else { const int j = m - NPR; if (!(j & 3)) sprev = a.state_shift + (size_t)(j >> 2) * RWC + 3072 + c0; }
        unsigned pk[8];
#pragma unroll
        for (int q4 = 0; q4 < 4; ++q4) {
            const f32x4 p = ldb4(prow + 4 * q4); const f32x4 pv = sprev ? ldg4(sprev + 4 * q4) : ldb4(pprev + 4 * q4) * pm;
            const f32x4 mu = ldg4(a.mu + 3072 + c0 + 4 * q4);
            f32x4 x = p + (pv - p) * mu;
            const int cc = c0 + 4 * q4;
            if (cc < 64) { x.x = tanhf_(x.x); x.y = tanhf_(x.y); x.z = tanhf_(x.z); x.w = tanhf_(x.w); }
            else if (cc >= 128) { x.x = sigmoidf_(x.x); x.y = sigmoidf_(x.y); x.z = sigmoidf_(x.z); x.w = sigmoidf_(x.w); }
            pk[2 * q4] = pk2(x.x, x.y); pk[2 * q4 + 1] = pk2(x.z, x.w);
        }
        LAS u32x4* d = (LAS u32x4*)(A2 + tk * 264 + c0);
        d[0] = (u32x4){pk[0], pk[1], pk[2], pk[3]}; d[1] = (u32x4){pk[4], pk[5], pk[6], pk[7]};
    }
    __syncthreads();
    const int mt = wave & 1, nt = wave >> 1;
    const LAS bf16* arow = A2 + (mt * 16 + l15) * 264 + quad * 8;
    {
        const int h0 = hq * 4;
#pragma unroll
        for (int hh = 0; hh < 4; ++hh) {
            const int n = (h0 + hh) * 64 + nt * 16 + l15;
            f32x4 cw = {0.f, 0.f, 0.f, 0.f}, ca = cw, cg = cw;
#pragma unroll
            for (int ks = 0; ks < 2; ++ks) {
                const bf16x8 av = *(const LAS bf16x8*)(arow + 32 * ks), bv = *(const GAS bf16x8*)(a.W2t + n * 64 + 32 * ks + quad * 8);
                cw = __builtin_amdgcn_mfma_f32_16x16x32_bf16(av, bv, cw, 0, 0, 0);
                const bf16x8 av2 = *(const LAS bf16x8*)(arow + 64 + 32 * ks), bv2 = *(const GAS bf16x8*)(a.A2t + n * 64 + 32 * ks + quad * 8);
                ca = __builtin_amdgcn_mfma_f32_16x16x32_bf16(av2, bv2, ca, 0, 0, 0);
            }
#pragma unroll
            for (int ks = 0; ks < 4; ++ks) {
                const bf16x8 av = *(const LAS bf16x8*)(arow + 128 + 32 * ks), bv = *(const GAS bf16x8*)(a.G2t + n * 128 + 32 * ks + quad * 8);
                cg = __builtin_amdgcn_mfma_f32_16x16x32_bf16(av, bv, cg, 0, 0, 0);
            }
#pragma unroll
            for (int j = 0; j < 4; ++j) {
                const int o = hh * (3 * 32 * 68) + (mt * 16 + quad * 4 + j) * 68 + nt * 16 + l15;
                LL[o] = cw[j]; LL[32 * 68 + o] = ca[j]; LL[2 * 32 * 68 + o] = cg[j];
            }
        }
        __syncthreads();
        {
            const int tk = wave * 4 + (lane >> 4); const int m = m0 + tk;
            const bf16* prow = a.P + (size_t)m * PLD;
            const bf16* pprev = prow - PLD; const float* sprev = nullptr; float pm = 1.f;
            if (m < NPR) { if (!(m & (SEQ - 1))) { pprev = prow; pm = 0.f; } }
            else { const int j = m - NPR; if (!(j & 3)) sprev = a.state_shift + (size_t)(j >> 2) * RWC; }
            f32x4 pr[4], pk_[4], pv[4], qr[4], qk[4], qv[4];
#pragma unroll
            for (int hh = 0; hh < 4; ++hh) { const int col = (h0 + hh) * 64 + 4 * l15;
                pr[hh] = ldb4(prow + col); pk_[hh] = ldb4(prow + 1024 + col); pv[hh] = ldb4(prow + 2048 + col);
                if (sprev) { qr[hh] = ldg4(sprev + col); qk[hh] = ldg4(sprev + 1024 + col); qv[hh] = ldg4(sprev + 2048 + col); }
                else { qr[hh] = ldb4(pprev + col) * pm; qk[hh] = ldb4(pprev + 1024 + col) * pm; qv[hh] = ldb4(pprev + 2048 + col) * pm; } }
#pragma unroll
            for (int hh = 0; hh < 4; ++hh) {
                const int col = (h0 + hh) * 64 + 4 * l15;
                const f32x4 mur = ldg4(a.mu + col), muk = ldg4(a.mu + 1024 + col), muv = ldg4(a.mu + 2048 + col);
                const f32x4 w0 = ldg4(a.w0 + col), a0 = ldg4(a.a0 + col), kkw = ldg4(a.kkw + col), kaw = ldg4(a.kaw + col);
                const LAS float* L0 = LL + hh * (3 * 32 * 68) + tk * 68 + 4 * l15;
                const f32x4 lw4 = *(const LAS f32x4*)L0, la4 = *(const LAS f32x4*)(L0 + 32 * 68), g4 = *(const LAS f32x4*)(L0 + 2 * 32 * 68);
                const f32x4 r4 = pr[hh] + (qr[hh] - pr[hh]) * mur, k4 = pk_[hh] + (qk[hh] - pk_[hh]) * muk, v4 = pv[hh] + (qv[hh] - pv[hh]) * muv;
                const f32x4 kkv = k4 * kkw;
                const float n2 = reduce16(dot4(kkv, kkv)); const float rn = rsqf_(n2 + 1e-12f);
                f32x4 dec, k2, am, bm;
#pragma unroll
                for (int e = 0; e < 4; ++e) {
                    const float lw = lw4[e] + w0[e];
                    const float wlog = -softplusf_(-lw) - 0.5f;
                    dec[e] = __expf(-__expf(wlog));
                    const float av = sigmoidf_(a0[e] + la4[e]);
                    const float kk = kkv[e] * rn;
                    k2[e] = k4[e] * (1.0f + (av - 1.0f) * kaw[e]);
                    am[e] = -kk; bm[e] = kk * av;
                }
                const size_t o = (size_t)m * 1024 + col;
                stg4(a.R + o, r4); stg4(a.W + o, dec); stg4(a.K + o, k2); stg4(a.V + o, v4); stg4(a.A + o, am); stg4(a.B + o, bm); stg4(a.G + o, g4);
            }
        }
        __syncthreads();
    }
}
__device__ __forceinline__ void prep_gd_pair(const PrepArgs& a, int q, int lane) {
    const int m = q >> 2, hp = q & 3; const int h = 2 * hp + (lane >> 5), c4 = 4 * (lane & 31);
    int t, sbase; const float* cprev;
    if (m < NPR) { t = m & (SEQ - 1); sbase = m - t; cprev = nullptr; }
    else { const int j = m - NPR; t = j & 3; sbase = m - t; cprev = a.state_conv + (size_t)(j >> 2) * 3 * 3072; }
    f32x4 acc[3];
#pragma unroll
    for (int s3 = 0; s3 < 3; ++s3) acc[s3] = (f32x4){0.f, 0.f, 0.f, 0.f};
#pragma unroll
    for (int j = 0; j < 4; ++j) {
        const int xi = t + j; const bf16* src = a.P + (size_t)m * PLD + GD0; const float* fsrc = nullptr; float fm = 1.f;
        if (xi >= 3) src = a.P + (size_t)(sbase + xi - 3) * PLD + GD0;
        else if (cprev) fsrc = cprev + (size_t)xi * 3072;
        else fm = 0.f;
#pragma unroll
        for (int s3 = 0; s3 < 3; ++s3) { const int cc = s3 * 1024 + h * 128 + c4; const f32x4 x = fsrc ? ldg4(fsrc + cc) : ldb4(src + cc) * fm; acc[s3] += x * ldg4(a.convw + j * 3072 + cc); }
    }
#pragma unroll
    for (int s3 = 0; s3 < 3; ++s3)
#pragma unroll
        for (int e = 0; e < 4; ++e) { const float x = acc[s3][e]; acc[s3][e] = x * sigmoidf_(x); }
    float qn = reduce16(dot4(acc[0], acc[0])), kn = reduce16(dot4(acc[1], acc[1]));
    qn += __shfl_xor(qn, 16); kn += __shfl_xor(kn, 16);
    const float qs = rsqf_(qn + 1e-12f) * 0.08838834764831845f, ks = rsqf_(kn + 1e-12f);
    const size_t o = (size_t)m * 1024 + h * 128 + c4;
    stg4(a.QG + o, acc[0] * qs); stg4(a.KG + o, acc[1] * ks); stg4(a.VG + o, acc[2]);
    if ((lane & 31) == 0) {
        const float braw = ldb1(a.P + (size_t)m * PLD + GD0 + 4096 + h), araw = ldb1(a.P + (size_t)m * PLD + GD0 + 4104 + h);
        stg1(a.BETA + (size_t)m * 1024 + h * 2, sigmoidf_(braw));
        stg1(a.BETA + (size_t)m * 1024 + h * 2 + 1, __expf(-__expf(ldg1(a.alog + h)) * softplusf_(araw + ldg1(a.dtb + h))));
    }
}
__device__ __forceinline__ void prep_copy_unit(const PrepArgs& a, int u, int lane) {
    const bf16* src; float* dst; int n4;
    if (u < 396) { const int seq = u / 3, i = u - seq * 3; n4 = 768;
        if (seq < 4) { src = a.P + (size_t)(seq * SEQ + SEQ - 3 + i) * PLD + GD0; dst = a.o_pcv + (size_t)(seq * 3 + i) * 3072; }
        else { const int b = seq - 4; src = a.P + (size_t)(NPR + 4 * b + 1 + i) * PLD + GD0; dst = a.o_scv + (size_t)(b * 3 + i) * 3072; } }
    else { const int v = u - 396; n4 = 832;
        if (v < 4) { src = a.P + (size_t)(v * SEQ + SEQ - 1) * PLD; dst = a.o_psh + (size_t)v * RWC; }
        else { const int b = v - 4; src = a.P + (size_t)(NPR + 4 * b + 3) * PLD; dst = a.o_ssh + (size_t)b * RWC; } }
    for (int c = lane; c < n4; c += 64) stg4(dst + 4 * c, ldb4(src + 4 * c));
}

struct ScanArgs {
    const float *R, *W, *K, *V, *A, *B, *QG, *KG, *VG, *BETA, *GDEC;
    const float *st_rw, *st_gd;
    float *ORW, *OGD;
    float *o_prw, *o_pgd, *o_srw, *o_sgd;
};
constexpr int TC = 16, RW_STEP = 336, GD_STEP = 276, SC_BUF = TC * (RW_STEP + GD_STEP);
__device__ __forceinline__ unsigned sc_slot(bool rw, int i, int t2, int m0, int h, int part) {
    const int idx = t2 + 256 * i; unsigned eo = 0u;
    if (rw) {
        if (idx < TC * 84) {
            const int stp = idx / 84, f4 = idx - stp * 84; const int vec = f4 >> 4, o4 = (f4 & 15) * 4;
            const unsigned arr = vec == 0 ? 1u : vec == 1 ? 4u : vec == 2 ? 5u : vec == 3 ? 2u : vec == 4 ? 0u : 3u;
            eo = arr * SCBF + (unsigned)(m0 + stp) * 1024u + h * 64 + (vec == 5 ? part * 16 + o4 : o4);
        }
    } else {
        if (i < 5 && idx < TC * 69) {
            const int stp = idx / 69, f4 = idx - stp * 69; const unsigned rb = (unsigned)(m0 + stp) * 1024u;
            if (f4 < 32) eo = 8u * SCBF + rb + h * 128 + f4 * 4;
            else if (f4 < 64) eo = 7u * SCBF + rb + h * 128 + (f4 - 32) * 4;
            else if (f4 < 68) eo = 9u * SCBF + rb + h * 128 + part * 16 + (f4 - 64) * 4;
            else eo = 10u * SCBF + rb + h * 2;
        }
    }
    return eo * 4u;
}
__device__ __forceinline__ f32x4 sc_load(const float* base, unsigned boff, int c) {
    return *(const GAS f32x4*)((const GAS char*)base + (boff + (unsigned)c * (TC * 1024u * 4u)));
}
__device__ __forceinline__ void sc_store(LAS float* bf, bool rw, int i, int t2, f32x4 v) {
    const int idx = t2 + 256 * i;
    if (rw) { if (idx < TC * 84) { const int stp = idx / 84, f4 = idx - stp * 84; *(LAS f32x4*)(bf + stp * RW_STEP + f4 * 4) = v; } }
    else { if (i < 5 && idx < TC * 69) { const int stp = idx / 69, f4 = idx - stp * 69; *(LAS f32x4*)(bf + TC * RW_STEP + stp * GD_STEP + f4 * 4) = v; } }
}
template <int NI> __device__ __forceinline__ void scan_sample_rw(const ScanArgs& a, int q, int lane) {
    const int grp16 = lane >> 4, l15 = lane & 15, ks = l15 * 4;
    f32x4 s[NI], w[NI][4], av[NI][4], bv[NI][4], kv[NI][4], rv[NI][4]; float vv[NI][4]; size_t so[NI]; int m0[NI], oc[NI];
#pragma unroll
    for (int ii = 0; ii < NI; ++ii) {
        const int j = NI * q + ii; const int bh = j >> 4, g = j & 15; const int b = bh >> 4, h = bh & 15; const int row = 4 * g + grp16;
        m0[ii] = NPR + 4 * b; oc[ii] = h * 64 + row; so[ii] = (size_t)bh * 4096 + row * 64 + ks;
        s[ii] = ldg4(a.st_rw + so[ii]);
#pragma unroll
        for (int t = 0; t < 4; ++t) { const size_t o = (size_t)(m0[ii] + t) * 1024 + h * 64;
            w[ii][t] = ldg4(a.W + o + ks); av[ii][t] = ldg4(a.A + o + ks); bv[ii][t] = ldg4(a.B + o + ks); kv[ii][t] = ldg4(a.K + o + ks); rv[ii][t] = ldg4(a.R + o + ks); vv[ii][t] = ldg1(a.V + o + row); }
    }
#pragma unroll
    for (int ii = 0; ii < NI; ++ii) {
        float osave = 0.f;
#pragma unroll
        for (int t = 0; t < 4; ++t) {
            const float sa = reduce16(dot4(s[ii], av[ii][t]));
            s[ii] = s[ii] * w[ii][t] + (bv[ii][t] * sa + kv[ii][t] * vv[ii][t]);
            const float o = reduce16(dot4(s[ii], rv[ii][t]));
            osave = (l15 == t) ? o : osave;
        }
        if (l15 < 4) stg1(a.ORW + (size_t)(m0[ii] + l15) * 1024 + oc[ii], osave);
        stg4(a.o_srw + so[ii], s[ii]);
    }
}
template <int NI> __device__ __forceinline__ void scan_sample_gd(const ScanArgs& a, int q, int lane) {
    const int grp16 = lane >> 4, l15 = lane & 15, ks = l15 * 8;
    f32x4 s0[NI], s1[NI], k0[NI][4], k1[NI][4], q0[NI][4], q1[NI][4]; float vv[NI][4], be[NI][4], gd[NI][4]; size_t so[NI]; int m0[NI], oc[NI];
#pragma unroll
    for (int ii = 0; ii < NI; ++ii) {
        const int j = NI * q + ii; const int bh = j >> 5, g = j & 31; const int b = bh >> 3, h = bh & 7; const int col = 4 * g + grp16;
        m0[ii] = NPR + 4 * b; oc[ii] = h * 128 + col; so[ii] = (size_t)bh * 16384 + (size_t)ks * 128 + col;
        const float* sp = a.st_gd + so[ii];
        s0[ii] = (f32x4){ldg1(sp), ldg1(sp + 128), ldg1(sp + 256), ldg1(sp + 384)}; s1[ii] = (f32x4){ldg1(sp + 512), ldg1(sp + 640), ldg1(sp + 768), ldg1(sp + 896)};
#pragma unroll
        for (int t = 0; t < 4; ++t) { const int m = m0[ii] + t; const size_t o = (size_t)m * 1024 + h * 128;
            k0[ii][t] = ldg4(a.KG + o + ks); k1[ii][t] = ldg4(a.KG + o + ks + 4); q0[ii][t] = ldg4(a.QG + o + ks); q1[ii][t] = ldg4(a.QG + o + ks + 4);
            vv[ii][t] = ldg1(a.VG + o + col); be[ii][t] = ldg1(a.BETA + (size_t)m * 1024 + h * 2); gd[ii][t] = ldg1(a.BETA + (size_t)m * 1024 + h * 2 + 1); }
    }
#pragma unroll
    for (int ii = 0; ii < NI; ++ii) {
        float osave = 0.f;
#pragma unroll
        for (int t = 0; t < 4; ++t) {
            const float d = reduce16(dot8(s0[ii], s1[ii], k0[ii][t], k1[ii][t]));
            const float gdec = gd[ii][t]; const float cc = be[ii][t] * (vv[ii][t] - gdec * d);
            s0[ii] = s0[ii] * gdec + k0[ii][t] * cc; s1[ii] = s1[ii] * gdec + k1[ii][t] * cc;
            const float o = reduce16(dot8(s0[ii], s1[ii], q0[ii][t], q1[ii][t]));
            osave = (l15 == t) ? o : osave;
        }
        if (l15 < 4) stg1(a.OGD + (size_t)(m0[ii] + l15) * 1024 + oc[ii], osave);
        float* sp = a.o_sgd + so[ii];
        stg1(sp, s0[ii].x); stg1(sp + 128, s0[ii].y); stg1(sp + 256, s0[ii].z); stg1(sp + 384, s0[ii].w);
        stg1(sp + 512, s1[ii].x); stg1(sp + 640, s1[ii].y); stg1(sp + 768, s1[ii].z); stg1(sp + 896, s1[ii].w);
    }
}

__device__ __forceinline__ void scan_prompt(const ScanArgs& a, LAS unsigned char* lds, int it, int tid, int wave, int lane, int hw, bool conv, const Args& args, unsigned char* convdst) {
    LAS float* buf = (LAS float*)lds;
    const bool rw = tid < 256; const int t2 = tid & 255;
    const int l15 = lane & 15, grp16 = lane >> 4;
    const int bh_r = it >> 2, part_r = it & 3, b_r = bh_r >> 4, h_r = bh_r & 15;
    const int bh_g = it >> 3, part_g = it & 7, b_g = bh_g >> 3, h_g = bh_g & 7;
    const int m0l = (rw ? b_r : b_g) * SEQ, hl = rw ? h_r : h_g, partl = rw ? part_r : part_g;
    unsigned e0 = sc_slot(rw, 0, t2, m0l, hl, partl); asm volatile("" : "+v"(e0));
    unsigned e1 = sc_slot(rw, 1, t2, m0l, hl, partl); asm volatile("" : "+v"(e1));
    unsigned e2 = sc_slot(rw, 2, t2, m0l, hl, partl); asm volatile("" : "+v"(e2));
    unsigned e3 = sc_slot(rw, 3, t2, m0l, hl, partl); asm volatile("" : "+v"(e3));
    unsigned e4 = sc_slot(rw, 4, t2, m0l, hl, partl); asm volatile("" : "+v"(e4));
    unsigned e5 = sc_slot(rw, 5, t2, m0l, hl, partl); asm volatile("" : "+v"(e5));
    constexpr int nch = SEQ / TC;
    f32x4 st0, st1, st2, st3, st4, st5;
#define SC_LOAD_ALL(c_) do { const int cc_ = (c_); st0 = sc_load(a.R, e0, cc_); st1 = sc_load(a.R, e1, cc_); st2 = sc_load(a.R, e2, cc_); st3 = sc_load(a.R, e3, cc_); st4 = sc_load(a.R, e4, cc_); st5 = sc_load(a.R, e5, cc_); } while (0)
#define SC_STORE_ALL(bf_) do { LAS float* b_ = (bf_); sc_store(b_, rw, 0, t2, st0); sc_store(b_, rw, 1, t2, st1); sc_store(b_, rw, 2, t2, st2); sc_store(b_, rw, 3, t2, st3); sc_store(b_, rw, 4, t2, st4); sc_store(b_, rw, 5, t2, st5); } while (0)
    f32x4 sa0 = {0.f, 0.f, 0.f, 0.f}, sa1 = sa0, sb0 = sa0, sb1 = sa0;
    const int cw = wave & 1;
    const int rl = cw * 8 + grp16 * 2;
    const int rc = (wave < 2 ? part_g : part_r) * 16 + rl;
    SC_LOAD_ALL(0); SC_STORE_ALL(buf); __syncthreads();
    if (wave < 4) __builtin_amdgcn_s_setprio(3);
    for (int c = 0; c < nch; ++c) {
        LAS float* cur = buf + (c & 1) * SC_BUF;
        if (c + 1 < nch) SC_LOAD_ALL(c + 1);
        float* op = nullptr; f32x2 ov = {0.f, 0.f};
        if (wave >= 4) {
            int lane2 = lane; asm volatile("" : "+v"(lane2));
            if (c & 1) { const int u = hw + 1024 * (c >> 1); if (u < 32768) scan_sample_rw<1>(a, u, lane2); else scan_sample_gd<1>(a, u - 32768, lane2); }
            if (conv && (c & 7) == 2 && c < 112) { const int ci = hw + 1024 * (c >> 3);
#define INL(i) ({ int _i = (i); asm volatile("" : "+s"(_i)); args.in[_i]; })
                const LayerW L1{INL(9) + (size_t)DM * INC, INL(25) + (size_t)DM * DM, INL(28) + (size_t)DM * XAW, INL(29) + (size_t)DM * XAW, INL(30) + (size_t)DM * XAW,
                                INL(31) + (size_t)XAW * DM, INL(34) + (size_t)DM * FF, INL(35) + (size_t)DM * FF, INL(36) + (size_t)FF * DM, INL(12) + 65536, INL(14) + 65536, INL(15) + 131072};
                if (ci < CONV_NIT) convert_item(L1, convdst, (float*)((unsigned char*)lds + 2 * SC_BUF * 4) + (wave - 4) * 4160, ci, lane2); }
        } else if (wave == 2 || wave == 3) {
            const LAS float* bs = cur + l15 * 4; const LAS float* bv = cur + 320 + rl;
            float osa = 0.f, osb = 0.f;
            f32x4 w4 = *(const LAS f32x4*)bs, a4 = *(const LAS f32x4*)(bs + 64), b4 = *(const LAS f32x4*)(bs + 128), k4 = *(const LAS f32x4*)(bs + 192), r4 = *(const LAS f32x4*)(bs + 256);
            f32x2 vv = *(const LAS f32x2*)bv;
#pragma unroll
            for (int stp = 0; stp < TC; ++stp) {
                f32x4 nw = w4, na = a4, nb = b4, nk = k4, nr = r4; f32x2 nv = vv;
                if (stp + 1 < TC) { const LAS float* p = bs + (stp + 1) * RW_STEP;
                    nw = *(const LAS f32x4*)p; na = *(const LAS f32x4*)(p + 64); nb = *(const LAS f32x4*)(p + 128); nk = *(const LAS f32x4*)(p + 192); nr = *(const LAS f32x4*)(p + 256); nv = *(const LAS f32x2*)(bv + (stp + 1) * RW_STEP); }
                const float da = reduce16(dot4(sa0, a4)), db = reduce16(dot4(sb0, a4));
                sa0 = sa0 * w4 + (b4 * da + k4 * vv.x); sb0 = sb0 * w4 + (b4 * db + k4 * vv.y);
                const float oa = reduce16(dot4(sa0, r4)), ob = reduce16(dot4(sb0, r4));
                osa = (l15 == stp) ? oa : osa; osb = (l15 == stp) ? ob : osb;
                w4 = nw; a4 = na; b4 = nb; k4 = nk; r4 = nr; vv = nv;
            }
            op = a.ORW + (size_t)(b_r * SEQ + c * TC + l15) * 1024 + h_r * 64 + rc; ov = (f32x2){osa, osb};
        } else if (wave < 2) {
            const LAS float* bs = cur + TC * RW_STEP + l15 * 8; const LAS float* bv = cur + TC * RW_STEP + 256 + rl; const LAS float* bg = cur + TC * RW_STEP + 272;
            float osa = 0.f, osb = 0.f;
            f32x4 k0 = *(const LAS f32x4*)bs, k1 = *(const LAS f32x4*)(bs + 4), q0 = *(const LAS f32x4*)(bs + 128), q1 = *(const LAS f32x4*)(bs + 132);
            f32x2 vv = *(const LAS f32x2*)bv; f32x2 bg2 = *(const LAS f32x2*)bg;
#pragma unroll
            for (int stp = 0; stp < TC; ++stp) {
                f32x4 nk0 = k0, nk1 = k1, nq0 = q0, nq1 = q1; f32x2 nv = vv; f32x2 nbg = bg2;
                if (stp + 1 < TC) { const LAS float* p = bs + (stp + 1) * GD_STEP;
                    nk0 = *(const LAS f32x4*)p; nk1 = *(const LAS f32x4*)(p + 4); nq0 = *(const LAS f32x4*)(p + 128); nq1 = *(const LAS f32x4*)(p + 132); nv = *(const LAS f32x2*)(bv + (stp + 1) * GD_STEP); nbg = *(const LAS f32x2*)(bg + (stp + 1) * GD_STEP); }
                const float da = reduce16(dot8(sa0, sa1, k0, k1)), db = reduce16(dot8(sb0, sb1, k0, k1));
                const float gdec = bg2.y; const float ca = bg2.x * (vv.x - gdec * da), cb = bg2.x * (vv.y - gdec * db);
                sa0 = sa0 * gdec + k0 * ca; sa1 = sa1 * gdec + k1 * ca; sb0 = sb0 * gdec + k0 * cb; sb1 = sb1 * gdec + k1 * cb;
                const float oa = reduce16(dot8(sa0, sa1, q0, q1)), ob = reduce16(dot8(sb0, sb1, q0, q1));
                osa = (l15 == stp) ? oa : osa; osb = (l15 == stp) ? ob : osb;
                k0 = nk0; k1 = nk1; q0 = nq0; q1 = nq1; vv = nv; bg2 = nbg;
            }
            op = a.OGD + (size_t)(b_g * SEQ + c * TC + l15) * 1024 + h_g * 128 + rc; ov = (f32x2){osa, osb};
        }
        if (c + 1 < nch) SC_STORE_ALL(buf + ((c + 1) & 1) * SC_BUF);
        if (wave < 4) *(GAS f32x2*)op = ov;
        asm volatile("s_waitcnt lgkmcnt(0)" ::: "memory"); __builtin_amdgcn_s_barrier(); asm volatile("" ::: "memory");
    }
    __builtin_amdgcn_s_setprio(0);
    if (wave == 2 || wave == 3) { float* sp = a.o_prw + (size_t)bh_r * 4096 + rc * 64 + l15 * 4; stg4(sp, sa0); stg4(sp + 64, sb0); }
    else if (wave < 2) { float* sp = a.o_pgd + (size_t)bh_g * 16384 + (size_t)(l15 * 8) * 128 + rc;
#pragma unroll
        for (int e = 0; e < 4; ++e) { *(GAS f32x2*)(sp + (size_t)e * 128) = (f32x2){sa0[e], sb0[e]}; *(GAS f32x2*)(sp + (size_t)(4 + e) * 128) = (f32x2){sa1[e], sb1[e]}; } }
}

struct PostArgs {
    const bf16* P; const float *R, *K, *V, *G, *ORW, *OGD; const float *rk, *lnxw, *lnxb, *normw; bf16* MIX;
};
__device__ __forceinline__ void post_row(const PostArgs& a, int m, int lane) {
    const size_t rb = (size_t)m * 1024;
    f32x4 o[4], r[4], k[4], v[4], g[4];
#pragma unroll
    for (int j = 0; j < 4; ++j) { const int col = j * 256 + 4 * lane;
        o[j] = ldg4(a.ORW + rb + col); r[j] = ldg4(a.R + rb + col); k[j] = ldg4(a.K + rb + col); v[j] = ldg4(a.V + rb + col); g[j] = ldg4(a.G + rb + col); }
#pragma unroll
    for (int j = 0; j < 4; ++j) { const int col = j * 256 + 4 * lane;
        const f32x4 lw = ldg4(a.lnxw + col), lb = ldg4(a.lnxb + col), rk = ldg4(a.rk + col);
        const float mu = reduce16((o[j].x + o[j].y) + (o[j].z + o[j].w)) * (1.f / 64.f); const f32x4 d = o[j] - mu;
        const float var = reduce16(dot4(d, d)) * (1.f / 64.f); const float rs = rsqf_(var + 64e-5f);
        const float bs = reduce16(dot4(r[j] * k[j], rk));
        const f32x4 y = (d * rs * lw + lb + v[j] * bs) * g[j];
        u32x2 w; w.x = pk2(y.x, y.y); w.y = pk2(y.z, y.w);
        *(GAS u32x2*)(a.MIX + (size_t)m * DM + col) = w; }
    f32x4 og[4], z[4];
#pragma unroll
    for (int j = 0; j < 4; ++j) { const int col = j * 256 + 4 * lane; og[j] = ldg4(a.OGD + rb + col); z[j] = ldb4(a.P + (size_t)m * PLD + GD0 + 3072 + col); }
    const f32x4 nw = ldg4(a.normw + 4 * (lane & 31));
#pragma unroll
    for (int j = 0; j < 4; ++j) { const int col = j * 256 + 4 * lane;
        float ms = reduce16(dot4(og[j], og[j])); ms += __shfl_xor(ms, 16); const float rs = rsqf_(ms * (1.f / 128.f) + 1e-6f);
        f32x4 y;
#pragma unroll
        for (int e = 0; e < 4; ++e) y[e] = og[j][e] * rs * nw[e] * (z[j][e] * sigmoidf_(z[j][e]));
        u32x2 w; w.x = pk2(y.x, y.y); w.y = pk2(y.z, y.w);
        *(GAS u32x2*)(a.MIX + (size_t)m * DM + 1024 + col) = w; }
}

constexpr int KP = 136, VP = 132;
__device__ __forceinline__ void attn_unit(const float* Kp, const float* Vp, const float* Q, bf16* AO, int mrow0, int nvalid, bool all_waves, int hcol,
                                          unsigned char* lds, int tid, int wave, int lane) {
    bf16* Ks = (bf16*)lds; bf16* Vs = Ks + 256 * KP;
#pragma unroll
    for (int i0 = 0; i0 < 16; i0 += 8) {
        f32x4 kk8[8], vv8[8];
#pragma unroll
        for (int j = 0; j < 8; ++j) { const int idx = tid + NTHR * (i0 + j); const int key = idx >> 5, d4 = (idx & 31) * 4;
            kk8[j] = ldg4(Kp + (size_t)key * 512 + d4); vv8[j] = ldg4(Vp + (size_t)key * 512 + d4); }
#pragma unroll
        for (int j = 0; j < 8; ++j) { const int idx = tid + NTHR * (i0 + j); const int key = idx >> 5, d4 = (idx & 31) * 4;
            const f32x4 kv = kk8[j], vv = vv8[j];
            u32x2 a, b; a.x = pk2(kv.x, kv.y); a.y = pk2(kv.z, kv.w); b.x = pk2(vv.x, vv.y); b.y = pk2(vv.z, vv.w);
            *(u32x2*)(Ks + key * KP + d4) = a; *(u32x2*)(Vs + key * VP + d4) = b; }
    }
    __syncthreads();
    if (all_waves || wave == 0) {
        const int quad = lane >> 4, l15 = lane & 15;
        const int qr = (all_waves ? wave * 16 : 0) + l15; const bool valid = qr < nvalid; const int m = mrow0 + qr;
        bf16x8 qf[4];
#pragma unroll
        for (int ds = 0; ds < 4; ++ds) {
            f32x4 x0 = {0.f, 0.f, 0.f, 0.f}, x1 = x0;
            if (valid) { const float* qp = Q + (size_t)m * XAW + hcol + 32 * ds + quad * 8; x0 = ldg4(qp); x1 = ldg4(qp + 4); }
            u32x4 w; w.x = pk2(x0.x, x0.y); w.y = pk2(x0.z, x0.w); w.z = pk2(x1.x, x1.y); w.w = pk2(x1.z, x1.w);
            qf[ds] = __builtin_bit_cast(bf16x8, w);
        }
        f32x4 sc[16];
#pragma unroll
        for (int kt = 0; kt < 16; ++kt) {
            sc[kt] = (f32x4){0.f, 0.f, 0.f, 0.f};
#pragma unroll
            for (int ds = 0; ds < 4; ++ds) {
                const bf16x8 kf = *(const bf16x8*)(Ks + (16 * kt + l15) * KP + 32 * ds + quad * 8);
                sc[kt] = __builtin_amdgcn_mfma_f32_16x16x32_bf16(kf, qf[ds], sc[kt], 0, 0, 0);
            }
        }
        float mx = -3.0e38f;
#pragma unroll
        for (int kt = 0; kt < 16; ++kt) mx = fmaxf(mx, fmaxf(fmaxf(sc[kt].x, sc[kt].y), fmaxf(sc[kt].z, sc[kt].w)));
        mx = fmaxf(mx, __shfl_xor(mx, 16)); mx = fmaxf(mx, __shfl_xor(mx, 32));
        const float c2 = 0.08838834764831845f * 1.4426950408889634f; float sum = 0.f;
        bf16x8 pb[8];
#pragma unroll
        for (int ks = 0; ks < 8; ++ks) {
            float p[8];
#pragma unroll
            for (int e = 0; e < 4; ++e) { p[e] = exp2f((sc[2 * ks][e] - mx) * c2); p[4 + e] = exp2f((sc[2 * ks + 1][e] - mx) * c2); }
            sum += ((p[0] + p[1]) + (p[2] + p[3])) + ((p[4] + p[5]) + (p[6] + p[7]));
            u32x4 w; w.x = pk2(p[0], p[1]); w.y = pk2(p[2], p[3]); w.z = pk2(p[4], p[5]); w.w = pk2(p[6], p[7]);
            pb[ks] = __builtin_bit_cast(bf16x8, w);
        }
        sum += __shfl_xor(sum, 16); sum += __shfl_xor(sum, 32);
        const float inv = rcpf_(sum);
#pragma unroll
        for (int nt = 0; nt < 8; ++nt) {
            f32x4 o = {0.f, 0.f, 0.f, 0.f};
            const bf16* vcol = Vs + 16 * nt + l15;
#pragma unroll
            for (int ks = 0; ks < 8; ++ks) {
                const bf16* v0 = vcol + (32 * ks + 4 * quad) * VP; const bf16* v1 = v0 + 16 * VP;
                u32x4 w;
                w.x = (unsigned)v0[0] | ((unsigned)v0[VP] << 16); w.y = (unsigned)v0[2 * VP] | ((unsigned)v0[3 * VP] << 16);
                w.z = (unsigned)v1[0] | ((unsigned)v1[VP] << 16); w.w = (unsigned)v1[2 * VP] | ((unsigned)v1[3 * VP] << 16);
                o = __builtin_amdgcn_mfma_f32_16x16x32_bf16(__builtin_bit_cast(bf16x8, w), pb[ks], o, 0, 0, 0);
            }
            if (valid) { u32x2 w; w.x = pk2(o.x * inv, o.y * inv); w.y = pk2(o.z * inv, o.w * inv); *(GAS u32x2*)(AO + (size_t)m * XAW + hcol + 16 * nt + quad * 4) = w; }
        }
    }
    __syncthreads();
}

#define RLX_AGENT __ATOMIC_RELAXED, __HIP_MEMORY_SCOPE_AGENT
#define XB_TMO      128
#define XB_XCNT(j)  (256  + 64 * (j))
#define XB_XSUB(j)  (1280 + 64 * (j))
#define XB_XGEN(j)  (2304 + 64 * (j))
#define XB_TOP      3328
#define XB_TOPGEN   3392
#define XCD_BAR_WORDS 3456
#define XB_SPIN_CAP (1u << 18)

__device__ __forceinline__ unsigned xb_ld(unsigned* p)              { return __hip_atomic_load(p, __ATOMIC_RELAXED, __HIP_MEMORY_SCOPE_AGENT); }
__device__ __forceinline__ unsigned xb_add(unsigned* p, unsigned v) { return __hip_atomic_fetch_add(p, v, __ATOMIC_RELAXED, __HIP_MEMORY_SCOPE_AGENT); }
__device__ __forceinline__ unsigned xb_xcc_id() { return (unsigned)__builtin_amdgcn_s_getreg((3 << 11) | 20) & 0xFu; }
#define XB_SPIN(cond, bar) do { unsigned _sp = 0; while (cond) { __builtin_amdgcn_s_sleep(1); \
    if ((++_sp & 255u) == 0u) { if (xb_ld(&(bar)[XB_TMO])) break; if (_sp > XB_SPIN_CAP) { atomicAdd(&(bar)[XB_TMO], 1u); break; } } } } while (0)

struct XcdBarrier {
    unsigned* bar; unsigned x;
    volatile LAS unsigned* st;
};

__device__ __forceinline__ XcdBarrier xcd_barrier_post(unsigned* bar, volatile LAS unsigned* st) {
    XcdBarrier b; b.bar = bar; b.x = xb_xcc_id(); b.st = st;
    if (threadIdx.x == 0) (void)xb_add(&bar[XB_XCNT(b.x)], 1u);
    return b;
}
__device__ __forceinline__ void xcd_barrier_complete(unsigned* bar, unsigned x, unsigned& nloc, unsigned& nx) {
    const unsigned G = gridDim.x * gridDim.y * gridDim.z;
    unsigned sum, cnt, mine, sp = 0u;
    for (;;) {
        sum = 0u; cnt = 0u; mine = 0u;
#pragma unroll
        for (unsigned j = 0; j < 16; ++j) { const unsigned c = xb_ld(&bar[XB_XCNT(j)]); sum += c; cnt += (c > 0u) ? 1u : 0u; mine = (j == x) ? c : mine; }
        if (sum == G) break;
        __builtin_amdgcn_s_sleep(1);
        if ((++sp & 255u) == 0u) { if (xb_ld(&bar[XB_TMO])) break; if (sp > XB_SPIN_CAP) { atomicAdd(&bar[XB_TMO], 1u); break; } }
    }
    nloc = mine > 0u ? mine : 1u; nx = cnt > 0u ? cnt : 1u;
}

__device__ __forceinline__ void xcd_barrier(const XcdBarrier& b) {
    asm volatile("s_waitcnt vmcnt(0)" ::: "memory");
    __syncthreads();
    if (threadIdx.x == 0) {
        unsigned* bar = b.bar;
        __builtin_amdgcn_s_waitcnt(0);
        unsigned nloc = b.st[0], nx = b.st[1];
        if (nloc == 0u) { xcd_barrier_complete(bar, b.x, nloc, nx); b.st[0] = nloc; b.st[1] = nx; }
        const unsigned old = xb_add(&bar[XB_XSUB(b.x)], 1u);
        const unsigned gen = old / nloc;
        if (old + 1u == (gen + 1u) * nloc) {
            __builtin_amdgcn_fence(__ATOMIC_RELEASE, "agent");
            asm volatile("s_waitcnt vmcnt(0)" ::: "memory");
            const unsigned og = xb_add(&bar[XB_TOP], 1u);
            const unsigned tg = og / nx;
            if (og + 1u == (tg + 1u) * nx) xb_add(&bar[XB_TOPGEN], 1u);
            else XB_SPIN(xb_ld(&bar[XB_TOPGEN]) == tg, bar);
            __builtin_amdgcn_fence(__ATOMIC_ACQUIRE, "agent");
            xb_add(&bar[XB_XGEN(b.x)], 1u);
            asm volatile("s_waitcnt vmcnt(0)" ::: "memory");
        } else {
            XB_SPIN(xb_ld(&bar[XB_XGEN(b.x)]) == gen, bar);
            __builtin_amdgcn_fence(__ATOMIC_ACQUIRE, "agent");
            asm volatile("s_waitcnt vmcnt(0)" ::: "memory");
        }
    }
    __syncthreads();
}

constexpr int NPHASE = 27;

#ifndef DUP_MASK
#define DUP_MASK 0
#endif
#ifndef SAMPLE_REPS
#define SAMPLE_REPS 1
#endif
__global__ void __launch_bounds__(NTHR, 2) fwd_megakernel(Args args) {
    extern __shared__ __attribute__((aligned(16))) unsigned char lds[];
    cg::grid_group grid = cg::this_grid();
    const int G = gridDim.x, bx = blockIdx.x;
    const int lo = args.ph_lo, hi = args.ph_hi;
#define IN(i) ({ int _i = (i); asm volatile("" : "+s"(_i)); args.in[_i]; })

    unsigned* barw = (unsigned*)(args.ws + 16384);
    volatile LAS unsigned* MISC = (volatile LAS unsigned*)((LAS unsigned char*)lds + (LDS_BYTES - 64));
    if (threadIdx.x < 16) MISC[threadIdx.x] = 0u;
    if (bx == 0) { for (int i = threadIdx.x; i < XCD_BAR_WORDS; i += NTHR) __hip_atomic_store(barw + i, 0u, RLX_AGENT); }
    __syncthreads();
    unsigned xid = 0; bool xposted = false;

    for (int ph = lo; ph < hi; ++ph) {
        if (ph > lo) {
            unsigned* bw = (unsigned*)(args.ws + 16384); asm volatile("" : "+s"(bw));
            if (!xposted) { grid.sync(); const XcdBarrier t = xcd_barrier_post(bw, MISC + 8); xid = t.x; xposted = true; }
            else { XcdBarrier t; t.bar = bw; t.x = xid; t.st = MISC + 8; xcd_barrier(t); }
        }
        const int nrep = ((DUP_MASK >> (ph == 0 ? 0 : ((ph - 1) % 13) + 1)) & 1) ? 2 : 1;
        for (int rep = 0; rep < nrep; ++rep) {
        int tid = threadIdx.x; asm volatile("" : "+v"(tid));
        const int lane = tid & 63, wave = __builtin_amdgcn_readfirstlane(tid >> 6);
        const int gw = bx * NWAVES + wave, NGW = G * NWAVES;
        unsigned char* ws = args.ws; asm volatile("" : "+s"(ws));
        float* out = args.out; asm volatile("" : "+s"(out));
        PG8_LAS unsigned char* ldsl = (PG8_LAS unsigned char*)lds;
        float* X = (float*)(ws + WS_X); bf16* Xb = (bf16*)(ws + WS_XB); float* PRE = (float*)(ws + WS_PRE); bf16* P = (bf16*)(ws + WS_P);
        const int l = ph == 0 ? 0 : (ph - 1) / 13; const int k = ph == 0 ? -1 : (ph - 1) % 13;
        unsigned char* wb = ws + (l ? W1OFF : 0);
        if (ph == 0) {
            LayerW L{IN(9), IN(25), IN(28), IN(29), IN(30), IN(31), IN(34), IN(35), IN(36), IN(12), IN(14), IN(15)};
            if (G == 256) { for (int i2 = gw; i2 < CONV_NIT - 2816; i2 += NGW) convert_item(L, ws, (float*)lds + wave * 4160, i2 < 9376 ? i2 : i2 + 2816, lane); }
            else convert_weights(L, ws, (float*)lds + wave * 4160, gw, NGW, lane);
            for (int m = gw; m < MROWS; m += NGW) row_copy_cvt(m < NPR ? IN(0) + (size_t)m * DM : IN(2) + (size_t)(m - NPR) * DM, nullptr, Xb + (size_t)m * DM, lane);
            for (int m = gw; m < 1024; m += NGW) row_copy_cvt(IN(1) + (size_t)m * DM, nullptr, (bf16*)(ws + WS_MEMB) + (size_t)m * DM, lane);
            continue;
        }
        if (k == 6 && l == 0 && G == 256 && (bx >= 68 && (bx < 128 || bx >= 144))) {
            const int idx = bx < 128 ? bx - 68 : bx - 144 + 60;
            LayerW L{IN(9), IN(25), IN(28), IN(29), IN(30), IN(31), IN(34), IN(35), IN(36), IN(12), IN(14), IN(15)};
            for (int i2 = idx * NWAVES + wave; i2 < 2816; i2 += 172 * NWAVES) convert_item(L, ws, (float*)lds + wave * 4160, 9376 + i2, lane);
            continue;
        }
        if (k == 0 || k == 4 || k == 6 || k == 8 || k == 10 || k == 11) {
            const int nsub = (k == 0 || k == 10) ? 1 : 2;
            for (int sub = 0; sub < nsub; ++sub) {
                pg8::Gemm g; pg8::EpiGen E; int cshift = 0;
                E.mode = 0; E.O = PRE; E.ldc = DM; E.res = X; E.alpha = ALPHA; E.split_cols = 0; E.split_stride = 0; E.H = (bf16*)(ws + WS_H); E.ldh = FF; E.nkt = 0; E.kplane = 0;
                g.A = Xb; g.M = MROWS; g.N = DM; g.K = DM; g.Bt = (const bf16*)(wb + WS_WOUT);
                if (k == 0) { g.Bt = (const bf16*)(wb + WS_WIN); g.N = PLD; E.mode = 3; E.H = P; E.ldh = PLD; E.res = nullptr; }
                else if (k == 4) { g.A = (const bf16*)(ws + WS_MIX); if (l == 0) E.res = IN(0); }
                else if (k == 6 && sub == 0) { g.Bt = (const bf16*)(wb + WS_WQ); g.N = XAW; E.O = (float*)(ws + WS_Q); E.ldc = XAW; E.res = nullptr; }
                else if (k == 6) { g.A = (const bf16*)(ws + WS_MEMB); g.Bt = (const bf16*)(wb + WS_WKV); g.M = 1024; g.N = 1024; cshift = 128;
                    E.O = out + O_PMK + (size_t)l * 4 * 256 * 512; E.ldc = 512; E.res = nullptr; E.split_cols = 512; E.split_stride = (size_t)(O_PMV - O_PMK); }
                else if (k == 8) { g.A = (const bf16*)(ws + WS_AO); g.Bt = (const bf16*)(wb + WS_WO); g.K = XAW; }
                else if (k == 10) { g.Bt = (const bf16*)(wb + WS_WGU); g.N = 2 * FF; E.mode = 1; }
                else { g.A = (const bf16*)(ws + WS_H); g.Bt = (const bf16*)(wb + WS_WD); g.K = FF; }
                int nsplit = 1;
                if ((k == 4 || k == 8 || k == 11) && sub == 0) { g.M = NPR; E.mode = 4; E.H = (bf16*)PRE; E.ldh = DM; }
                if ((k == 4 || k == 8 || k == 11) && sub == 1) {
                    g.A += (size_t)NPR * g.K; g.M = NSM; nsplit = (k == 4) ? 8 : (k == 8) ? 4 : 11;
                    E.O = (float*)(ws + WS_PART); E.res = (k == 4 && l == 0) ? IN(2) : X + (size_t)NPR * DM; E.nkt = g.K / 64 / nsplit; E.kplane = (size_t)NSM * DM; }
                g.nt = g.K / 64 / nsplit;
                pg8::StaticOrder S; S.init(g.M, g.N, G, (bx + cshift) % G); S.nsplit = nsplit; S.nkt = g.nt;
                pg8::gemm_phase<pg8::EpiGen, pg8::StaticOrder, true, true>(ldsl, g, S, E);
                __syncthreads();
            }
            continue;
        }
        switch (k) {
        case 1: {
            PrepArgs a;
            a.P = P; a.state_shift = IN(4) + (size_t)l * 128 * RWC; a.state_conv = IN(6) + (size_t)l * 128 * 3 * 3072;
            a.mu = IN(10) + l * RWC; a.w0 = IN(11) + l * 1024; a.a0 = IN(13) + l * 1024; a.kkw = IN(16) + l * 1024; a.kaw = IN(17) + l * 1024;
            a.convw = IN(21) + l * 4 * 3072; a.alog = IN(22) + l * 8; a.dtb = IN(23) + l * 8;
            a.W2t = (const bf16*)(wb + WS_LORA); a.A2t = a.W2t + 65536; a.G2t = a.W2t + 131072;
            a.R = (float*)(ws + WS_R); a.W = (float*)(ws + WS_W); a.K = (float*)(ws + WS_K); a.V = (float*)(ws + WS_V); a.A = (float*)(ws + WS_A); a.B = (float*)(ws + WS_B); a.G = (float*)(ws + WS_G);
            a.QG = (float*)(ws + WS_QG); a.KG = (float*)(ws + WS_KG); a.VG = (float*)(ws + WS_VG); a.BETA = (float*)(ws + WS_BG); a.GDEC = a.BETA + MROWS * 8;
            a.o_psh = out + O_PSH + (size_t)l * 4 * RWC; a.o_pcv = out + O_PCV + (size_t)l * 4 * 3 * 3072; a.o_ssh = out + O_SSH + (size_t)l * 128 * RWC; a.o_scv = out + O_SCV + (size_t)l * 128 * 3 * 3072;
            const int vcu1 = (G % 8 == 0) ? (bx % 8) * (G / 8) + bx / 8 : bx;
            for (int u = vcu1; u < (MROWS / 32) * 4; u += G) prep_rw_unit(a, ldsl, u, tid, wave, lane);
            for (int q = gw; q < MROWS * 4; q += NGW) prep_gd_pair(a, q, lane);
            for (int u = gw; u < 528; u += NGW) prep_copy_unit(a, u, lane);
        } break;
        case 2: {
            ScanArgs a;
            a.R = (const float*)(ws + WS_R); a.W = (const float*)(ws + WS_W); a.K = (const float*)(ws + WS_K); a.V = (const float*)(ws + WS_V); a.A = (const float*)(ws + WS_A); a.B = (const float*)(ws + WS_B);
            a.QG = (const float*)(ws + WS_QG); a.KG = (const float*)(ws + WS_KG); a.VG = (const float*)(ws + WS_VG); a.BETA = (const float*)(ws + WS_BG); a.GDEC = a.BETA + MROWS * 8;
            a.st_rw = IN(3) + (size_t)l * 128 * 16 * 4096; a.st_gd = IN(5) + (size_t)l * 128 * 8 * 16384;
            a.ORW = (float*)(ws + WS_ORW); a.OGD = (float*)(ws + WS_OGD);
            a.o_prw = out + O_PRW + (size_t)l * 4 * 16 * 4096; a.o_pgd = out + O_PGD + (size_t)l * 4 * 8 * 16384;
            a.o_srw = out + O_SRW + (size_t)l * 128 * 16 * 4096; a.o_sgd = out + O_SGD + (size_t)l * 128 * 8 * 16384;
            const int vcu = (G % 8 == 0) ? (bx % 8) * (G / 8) + bx / 8 : bx;
            if (G == 256) {
                scan_prompt(a, ldsl, vcu, tid, wave, lane, vcu * 4 + (wave & 3), l == 0, args, ws + W1OFF);
            } else {
                for (int it = vcu; it < 256; it += G) scan_prompt(a, ldsl, it, tid, wave, lane, 0, false, args, nullptr);
                for (int srep = 0; srep < SAMPLE_REPS; ++srep)
                for (int u = vcu * NWAVES + wave; u < 32768; u += NGW) { if (u < 16384) scan_sample_rw<2>(a, u, lane); else scan_sample_gd<2>(a, u - 16384, lane); }
            }
        } break;
        case 3: {
            PostArgs a;
            a.P = P; a.R = (const float*)(ws + WS_R); a.K = (const float*)(ws + WS_K); a.V = (const float*)(ws + WS_V); a.G = (const float*)(ws + WS_G);
            a.ORW = (const float*)(ws + WS_ORW); a.OGD = (const float*)(ws + WS_OGD);
            a.rk = IN(18) + l * 1024; a.lnxw = IN(19) + l * 1024; a.lnxb = IN(20) + l * 1024; a.normw = IN(24) + l * 128; a.MIX = (bf16*)(ws + WS_MIX);
            for (int m = gw; m < MROWS; m += NGW) post_row(a, m, lane);
        } break;
        case 5: case 9: case 12: {
            const int gi = k == 5 ? 26 : k == 9 ? 32 : 37;
            const float* gg = IN(gi) + l * DM; const float* bb = IN(gi + 1) + l * DM;
            const bool fin = (k == 12 && l == 1);
            int m = gw;
            const size_t rst = (size_t)NGW * DM;
            for (; m + 3 * NGW < NPR; m += 4 * NGW)
                ln_rows_n<4>((const bf16*)PRE + (size_t)m * DM, rst, gg, bb, fin ? out + O_YP + (size_t)m * DM : X + (size_t)m * DM, fin ? nullptr : Xb + (size_t)m * DM, lane);
            for (; m + NGW < NPR; m += 2 * NGW)
                ln_rows_n<2>((const bf16*)PRE + (size_t)m * DM, rst, gg, bb, fin ? out + O_YP + (size_t)m * DM : X + (size_t)m * DM, fin ? nullptr : Xb + (size_t)m * DM, lane);
            for (; m < MROWS; m += NGW) {
                float* df = fin ? (m < NPR ? out + O_YP + (size_t)m * DM : out + O_YS + (size_t)(m - NPR) * DM) : X + (size_t)m * DM;
                const bool smp = m >= NPR;
                ln_row((const float*)(ws + WS_PART) + (size_t)(smp ? m - NPR : 0) * DM, smp ? nullptr : (const bf16*)PRE + (size_t)m * DM, smp ? (k == 5 ? 8 : k == 9 ? 4 : 11) : 1, gg, bb, df, fin ? nullptr : Xb + (size_t)m * DM, lane);
            }
            if (k == 12 && l == 0 && G != 256) {
                LayerW L{IN(9) + (size_t)DM * INC, IN(25) + (size_t)DM * DM, IN(28) + (size_t)DM * XAW, IN(29) + (size_t)DM * XAW, IN(30) + (size_t)DM * XAW,
                         IN(31) + (size_t)XAW * DM, IN(34) + (size_t)DM * FF, IN(35) + (size_t)DM * FF, IN(36) + (size_t)FF * DM,
                         IN(12) + 65536, IN(14) + 65536, IN(15) + 131072};
                convert_weights(L, ws + W1OFF, (float*)lds + wave * 4160, gw, NGW, lane);
            }
        } break;
        case 7: {
            const float* Q = (const float*)(ws + WS_Q); bf16* AO = (bf16*)(ws + WS_AO);
            const int vcu7 = (G % 8 == 0) ? (bx % 8) * (G / 8) + bx / 8 : bx;
            for (int u = vcu7; u < 256 + 512; u += G) {
                if (u < 256) { const int b = u >> 6, h = (u >> 4) & 3, qb = u & 15;
                    const size_t kvo = ((size_t)(l * 4 + b) * 256) * 512 + h * 128;
                    attn_unit(out + O_PMK + kvo, out + O_PMV + kvo, Q, AO, b * SEQ + qb * 128, 128, true, h * 128, lds, tid, wave, lane);
                } else { const int j = u - 256; const int b = j >> 2, h = j & 3;
                    const size_t kvo = ((size_t)(l * 128 + b) * 256) * 512 + h * 128;
                    attn_unit(IN(7) + kvo, IN(8) + kvo, Q, AO, NPR + b * 4, 4, false, h * 128, lds, tid, wave, lane);
                }
            }
        } break;
        default: break;
        }
        }
    }
}

#ifndef MK_PER_PHASE
#define MK_PER_PHASE 0
#endif
extern "C" void kernel_launch(void* const* d_in, const int* in_sizes, int n_in, void* d_out, int out_size, void* d_ws, size_t ws_size, hipStream_t stream) {
    static int grid = 0;
    if (grid == 0) {
        if (n_in != 39 || (size_t)out_size != O_END || ws_size < WS_END) { fprintf(stderr, "kernel_launch: unexpected sizes n_in %d out %d ws %zu (need %zu)\n", n_in, out_size, ws_size, (size_t)WS_END); }
        int dev = 0, cus = 0, per_cu = 0;
        hipGetDevice(&dev); hipDeviceGetAttribute(&cus, hipDeviceAttributeMultiprocessorCount, dev);
        hipFuncSetAttribute((const void*)fwd_megakernel, hipFuncAttributeMaxDynamicSharedMemorySize, LDS_BYTES);
        hipOccupancyMaxActiveBlocksPerMultiprocessor(&per_cu, (const void*)fwd_megakernel, NTHR, LDS_BYTES);
        if (per_cu < 1) { fprintf(stderr, "kernel_launch: occupancy query says %d\n", per_cu); per_cu = 1; }
        grid = cus * 1;
        if (cus <= 0) grid = 256;
    }
    Args a{};
    for (int i = 0; i < 39; ++i) a.in[i] = (const float*)d_in[i];
    a.out = (float*)d_out; a.ws = (unsigned char*)d_ws;
#if MK_PER_PHASE
    for (int p = 0; p < NPHASE; ++p) { a.ph_lo = p; a.ph_hi = p + 1; void* kargs[] = {&a};
        hipError_t e = hipLaunchCooperativeKernel((const void*)fwd_megakernel, dim3(grid), dim3(NTHR), kargs, LDS_BYTES, stream);
        if (e != hipSuccess) { fprintf(stderr, "launch %d failed: %s\n", p, hipGetErrorString(e)); break; } }
#else
    a.ph_lo = 0; a.ph_hi = NPHASE; void* kargs[] = {&a};
    hipError_t e = hipLaunchCooperativeKernel((const void*)fwd_megakernel, dim3(grid), dim3(NTHR), kargs, LDS_BYTES, stream);
    if (e != hipSuccess) fprintf(stderr, "cooperative launch failed: %s (grid %d)\n", hipGetErrorString(e), grid);
#endif
}
```
